# Optimizing an MI355X kernel written in HIP

```python
import jax
import jax.numpy as jnp
from jax import lax
import numpy as np

D_MODEL = 1024
BATCH = 4
SEQ = 4096
DEPTH = 1

GRID_W = 64
CTX_LEN = 256
RET_HEADS = 4
RET_QK_DIM = 256
RET_V_DIM = 512
RET_QK_W = RET_HEADS * RET_QK_DIM
RET_V_W = RET_HEADS * RET_V_DIM
RET_CHUNK = 128
CONV_W = D_MODEL
CONV_K = 3
N_BRANCH = 2
N_GROUPS = 4
EXPERTS_PER_GROUP = 8
N_EXPERTS = N_GROUPS * EXPERTS_PER_GROUP
EXPERT_HIDDEN = 512
TOP_K_IN_GROUP = 2
ROPE_BASE = 10000.0
NORM_EPS = 1e-6
GN_EPS = 1e-5

OFF_Q = 0
OFF_K = OFF_Q + RET_QK_W
OFF_V = OFF_K + RET_QK_W
OFF_G = OFF_V + RET_V_W
OFF_CB = OFF_G + RET_V_W
OFF_CC = OFF_CB + CONV_W
OFF_CH = OFF_CC + CONV_W
OFF_GATE = OFF_CH + CONV_W
PROJ_W = OFF_GATE + N_BRANCH * D_MODEL

kernel_name = "hybrid_retention_shortconv_hmoe_dit"


def _rmsnorm(x, w):
    xf = x.astype(jnp.float32)
    y = xf * lax.rsqrt(jnp.mean(xf * xf, axis=-1, keepdims=True) + NORM_EPS)
    return (y * w.astype(jnp.float32)).astype(x.dtype)


def _modulate(h, shift, scale):
    return h * (1 + scale) + shift


def _split_heads(t, n_heads):
    b, l, _ = t.shape
    return t.reshape(b, l, n_heads, -1).transpose(0, 2, 1, 3)


def _rope_axis(u, pos):
    nf = u.shape[-1] // 2
    inv = ROPE_BASE ** (-jnp.arange(nf, dtype=jnp.float32) / nf)
    ang = pos[:, None] * inv[None, :]
    cos = jnp.cos(ang).astype(u.dtype)
    sin = jnp.sin(ang).astype(u.dtype)
    u1, u2 = u[..., :nf], u[..., nf:]
    return jnp.concatenate([u1 * cos - u2 * sin, u1 * sin + u2 * cos], axis=-1)


def _rope_2d(t):
    pos = jnp.arange(t.shape[2])
    row = (pos // GRID_W).astype(jnp.float32)
    col = (pos % GRID_W).astype(jnp.float32)
    half = t.shape[-1] // 2
    return jnp.concatenate([_rope_axis(t[..., :half], row), _rope_axis(t[..., half:], col)], axis=-1)


def _decay_logs(log_decay):
    return jnp.log1p(-jnp.exp(log_decay.astype(jnp.float32)))


def _retention_chunked(q, k, v, log_gamma, s0, strict):
    b, h, l, _ = q.shape
    dv = v.shape[-1]
    n_chunks = l // RET_CHUNK
    idx = jnp.arange(RET_CHUNK, dtype=jnp.float32)
    diff = idx[:, None] - idx[None, :]
    mask = (diff > 0) if strict else (diff >= 0)
    lg = log_gamma[:, None, None]
    intra = jnp.where(mask, jnp.exp(jnp.where(mask, diff, 0.0) * lg), 0.0)
    xi = jnp.exp((idx + 1.0)[None, :] * log_gamma[:, None])[:, :, None]
    zeta = jnp.exp((RET_CHUNK - 1.0 - idx)[None, :] * log_gamma[:, None])[:, :, None]
    chunk_decay = jnp.exp(RET_CHUNK * log_gamma)[:, None, None]

    def to_chunks(t):
        t = t.astype(jnp.float32).reshape(b, h, n_chunks, RET_CHUNK, t.shape[-1])
        return jnp.moveaxis(t, 2, 0)

    def step(state, qkv):
        qc, kc, vc = qkv
        scores = jnp.einsum('bhid,bhjd->bhij', qc, kc) * intra
        out = (jnp.einsum('bhij,bhje->bhie', scores, vc)
               + jnp.einsum('bhid,bhde->bhie', qc * xi, state))
        state = chunk_decay * state + jnp.einsum('bhjd,bhje->bhde', kc * zeta, vc)
        return state, out

    s_final, out = lax.scan(step, s0, (to_chunks(q), to_chunks(k), to_chunks(v)))
    return jnp.moveaxis(out, 0, 2).reshape(b, h, l, dv), s_final


def _bidir_retention(q, k, v, log_gamma, s_f, s_b):
    out_f, _ = _retention_chunked(q, k, v, log_gamma[0], s_f, strict=False)
    flip = lambda t: jnp.flip(t, axis=2)
    out_b, _ = _retention_chunked(flip(q), flip(k), flip(v), log_gamma[1], s_b, strict=True)
    return out_f + flip(out_b)


def _context_states(hc, w_in, log_decay):
    kv = hc @ w_in[:, OFF_K:OFF_G]
    k = _split_heads(kv[..., :RET_QK_W], RET_HEADS).astype(jnp.float32) * RET_QK_DIM ** -0.5
    v = _split_heads(kv[..., RET_QK_W:], RET_HEADS).astype(jnp.float32)
    lg = _decay_logs(log_decay)
    ctx_len = k.shape[2]
    pos = jnp.arange(ctx_len, dtype=jnp.float32)
    w_f = jnp.exp((ctx_len - 1.0 - pos)[None, :] * lg[0][:, None])[:, :, None]
    w_b = jnp.exp(pos[None, :] * lg[1][:, None])[:, :, None]
    s_f = jnp.einsum('bhld,bhle->bhde', k * w_f, v)
    s_b = jnp.einsum('bhld,bhle->bhde', k * w_b, v)
    return s_f, s_b


def _short_conv(u, conv_w, n_rows):
    b, l, ch = u.shape
    seqs = u.reshape(b * n_rows, GRID_W, ch) if n_rows is not None else u
    y = lax.conv_general_dilated(
        seqs, conv_w[:, None, :].astype(u.dtype), window_strides=(1,),
        padding=((CONV_K // 2, CONV_K // 2),),
        dimension_numbers=('NWC', 'WIO', 'NWC'), feature_group_count=ch)
    return y.reshape(b, l, ch)


def _token_mixers(h, w_in, log_decay, gn_w, w_ret_o, conv_w, w_conv_o, w_out, s_f, s_b, n_rows):
    b, l, _ = h.shape
    proj = h @ w_in
    q = _split_heads(proj[..., OFF_Q:OFF_K], RET_HEADS)
    k = _split_heads(proj[..., OFF_K:OFF_V], RET_HEADS) * RET_QK_DIM ** -0.5
    v = _split_heads(proj[..., OFF_V:OFF_G], RET_HEADS)
    if n_rows is not None:
        q, k = _rope_2d(q), _rope_2d(k)
    y = _bidir_retention(q, k, v, _decay_logs(log_decay), s_f, s_b)
    mu = jnp.mean(y, axis=-1, keepdims=True)
    var = jnp.mean(jnp.square(y - mu), axis=-1, keepdims=True)
    y = (y - mu) * lax.rsqrt(var + GN_EPS)
    y = y.transpose(0, 2, 1, 3).reshape(b, l, RET_V_W) * gn_w.astype(jnp.float32)
    y = jax.nn.silu(proj[..., OFF_G:OFF_CB]) * y.astype(h.dtype)
    ret_branch = y @ w_ret_o
    u = _short_conv(proj[..., OFF_CC:OFF_CH] * proj[..., OFF_CH:OFF_GATE], conv_w, n_rows)
    conv_branch = (proj[..., OFF_CB:OFF_CC] * u) @ w_conv_o
    gates = jax.nn.sigmoid(proj[..., OFF_GATE:])
    merged = gates[..., :D_MODEL] * ret_branch + gates[..., D_MODEL:] * conv_branch
    return merged @ w_out


def _hier_moe(h, rg_w, rg_b, re_w, re_b, w13, w2):
    b, l, d = h.shape
    t = h.reshape(-1, d)
    g_logits = (t @ rg_w + rg_b).astype(jnp.float32)
    g_prob = jax.nn.softmax(g_logits, axis=-1)
    g_idx = jnp.argmax(g_logits, axis=-1)
    g_w = jnp.take_along_axis(g_prob, g_idx[:, None], axis=1)
    e_logits = (t @ re_w + re_b).astype(jnp.float32).reshape(-1, N_GROUPS, EXPERTS_PER_GROUP)
    e_logits = jnp.take_along_axis(e_logits, g_idx[:, None, None], axis=1)[:, 0]
    e_prob = jax.nn.softmax(e_logits, axis=-1)
    top_w, top_i = lax.top_k(e_prob, TOP_K_IN_GROUP)
    top_w = top_w / jnp.sum(top_w, axis=-1, keepdims=True)
    expert_id = g_idx[:, None] * EXPERTS_PER_GROUP + top_i
    combine = jnp.sum(jax.nn.one_hot(expert_id, N_EXPERTS, dtype=jnp.float32)
                      * (g_w * top_w)[..., None], axis=1).astype(t.dtype)
    out = jnp.zeros_like(t)
    for e in range(N_EXPERTS):
        hid = t @ w13[e]
        act = jax.nn.silu(hid[:, :EXPERT_HIDDEN]) * hid[:, EXPERT_HIDDEN:]
        out = out + combine[:, e:e + 1] * (act @ w2[e])
    return out.reshape(b, l, d)


def setup_inputs(seed: int = 0) -> dict:
    key = jax.random.key(seed)
    ks = jax.random.split(key, 24)
    nrm = jax.random.normal
    f32 = jnp.float32
    base_decay = -(5.0 + jnp.arange(RET_HEADS, dtype=f32)) * np.float32(np.log(2.0))
    return {
        'x': nrm(ks[0], (BATCH, SEQ, D_MODEL), f32),
        'c': nrm(ks[1], (BATCH, D_MODEL), f32),
        'ctx': nrm(ks[2], (BATCH, CTX_LEN, D_MODEL), f32),
        'c_ctx': nrm(ks[3], (D_MODEL,), f32),
        'w_mod': nrm(ks[4], (DEPTH, D_MODEL, 6 * D_MODEL), f32) * (0.5 * D_MODEL ** -0.5),
        'b_mod': nrm(ks[5], (DEPTH, 6 * D_MODEL), f32) * 0.02,
        'norm1_w': 1.0 + 0.02 * nrm(ks[6], (DEPTH, D_MODEL), f32),
        'norm2_w': 1.0 + 0.02 * nrm(ks[7], (DEPTH, D_MODEL), f32),
        'w_in': nrm(ks[8], (DEPTH, D_MODEL, PROJ_W), f32) * D_MODEL ** -0.5,
        'ret_log_decay': base_decay[None, None, :] + 0.1 * nrm(ks[9], (DEPTH, 2, RET_HEADS), f32),
        'ret_gn_w': 1.0 + 0.02 * nrm(ks[10], (DEPTH, RET_V_W), f32),
        'w_ret_o': nrm(ks[11], (DEPTH, RET_V_W, D_MODEL), f32) * RET_V_W ** -0.5,
        'conv_w': nrm(ks[12], (DEPTH, CONV_K, CONV_W), f32) * CONV_K ** -0.5,
        'w_conv_o': nrm(ks[13], (DEPTH, CONV_W, D_MODEL), f32) * CONV_W ** -0.5,
        'w_out': nrm(ks[14], (DEPTH, D_MODEL, D_MODEL), f32) * D_MODEL ** -0.5,
        'router_group_w': nrm(ks[15], (DEPTH, D_MODEL, N_GROUPS), f32) * D_MODEL ** -0.5,
        'router_group_b': 0.01 * nrm(ks[16], (DEPTH, N_GROUPS), f32),
        'router_expert_w': nrm(ks[17], (DEPTH, D_MODEL, N_EXPERTS), f32) * D_MODEL ** -0.5,
        'router_expert_b': 0.01 * nrm(ks[18], (DEPTH, N_EXPERTS), f32),
        'expert_w13': nrm(ks[19], (DEPTH, N_EXPERTS, D_MODEL, 2 * EXPERT_HIDDEN), f32) * D_MODEL ** -0.5,
        'expert_w2': nrm(ks[20], (DEPTH, N_EXPERTS, EXPERT_HIDDEN, D_MODEL), f32) * EXPERT_HIDDEN ** -0.5,
        'final_norm_w': 1.0 + 0.02 * nrm(ks[21], (D_MODEL,), f32),
    }


def reference(x, c, ctx, c_ctx, w_mod, b_mod, norm1_w, norm2_w, w_in, ret_log_decay, ret_gn_w,
              w_ret_o, conv_w, w_conv_o, w_out, router_group_w, router_group_b, router_expert_w,
              router_expert_b, expert_w13, expert_w2, final_norm_w):
    n_rows = x.shape[1] // GRID_W
    for layer in range(DEPTH):
        mod_x = jnp.split((jax.nn.silu(c) @ w_mod[layer] + b_mod[layer])[:, None, :], 6, axis=-1)
        mod_c = jnp.split(jax.nn.silu(c_ctx) @ w_mod[layer] + b_mod[layer], 6, axis=-1)
        mixer_w = (w_in[layer], ret_log_decay[layer], ret_gn_w[layer], w_ret_o[layer],
                   conv_w[layer], w_conv_o[layer], w_out[layer])
        moe_w = (router_group_w[layer], router_group_b[layer], router_expert_w[layer],
                 router_expert_b[layer], expert_w13[layer], expert_w2[layer])
        hx = _modulate(_rmsnorm(x, norm1_w[layer]), mod_x[0], mod_x[1])
        hc = _modulate(_rmsnorm(ctx, norm1_w[layer]), mod_c[0], mod_c[1])
        s_f, s_b = _context_states(hc, w_in[layer], ret_log_decay[layer])
        x = x + mod_x[2] * _token_mixers(hx, *mixer_w, s_f, s_b, n_rows)
        if layer < DEPTH - 1:
            zero_state = jnp.zeros_like(s_f)
            ctx = ctx + mod_c[2] * _token_mixers(hc, *mixer_w, zero_state, zero_state, None)
            hc2 = _modulate(_rmsnorm(ctx, norm2_w[layer]), mod_c[3], mod_c[4])
            ctx = ctx + mod_c[5] * _hier_moe(hc2, *moe_w)
        hx2 = _modulate(_rmsnorm(x, norm2_w[layer]), mod_x[3], mod_x[4])
        x = x + mod_x[5] * _hier_moe(hx2, *moe_w)
    return _rmsnorm(x, final_norm_w)
```

```cpp
#include <hip/hip_runtime.h>
#include <cstdio>
#include <cstdint>

#define GAS __attribute__((address_space(1)))
#define LAS __attribute__((address_space(3)))
typedef unsigned short bf16;
typedef short bf16x8 __attribute__((ext_vector_type(8)));
typedef float f32x4 __attribute__((ext_vector_type(4)));
typedef unsigned v4u __attribute__((ext_vector_type(4)));
typedef unsigned v2u __attribute__((ext_vector_type(2)));

constexpr int DM = 1024, NB = 4, SEQ = 4096, T = NB * SEQ, CTXL = 256, TCX = NB * CTXL, TP = T + TCX;
constexpr int NH = 4, DK = 256, DV = 512, QKW = NH * DK, VW = NH * DV;
constexpr int CH = 256, NCH = SEQ / CH;
constexpr int PROJ_W = 11264;
constexpr int OFF_Q = 0, OFF_K = 1024, OFF_V = 2048, OFF_G = 4096, OFF_CB = 6144, OFF_CC = 7168, OFF_CH = 8192, OFF_GATE = 9216;
constexpr int R_Q = 0, R_K = 1024, R_V = 2048, R_G = 4096, R_CB = 6144, R_CCH = 7168, R_GATE = 9216;
constexpr int NE = 32, EH = 512;
constexpr int MAXSLOT = 2 * T + NE * 256;

constexpr size_t MiB = 1u << 20;
constexpr size_t WS_CTL = 0;
constexpr size_t WS_SMALL = 1 * MiB;
constexpr size_t SM_MOD = 0;
constexpr size_t SM_ROPE = 128 * 1024;
constexpr size_t SM_DEC = 192 * 1024;
constexpr size_t SM_TOKE = 256 * 1024;
constexpr size_t SM_TOKP = 384 * 1024;
constexpr size_t SM_TOKW = 512 * 1024;
constexpr size_t SM_TOKS = 640 * 1024;
constexpr size_t SM_SLOTW = 768 * 1024;
constexpr size_t WS_WCAT = 2 * MiB;
constexpr size_t WS_WOUT = 8 * MiB;
constexpr size_t WS_CBU = 11 * MiB;
constexpr size_t WS_SG = 43 * MiB;
constexpr size_t WS_ACAT = 107 * MiB;
constexpr size_t WS_KB = 203 * MiB;
constexpr size_t WS_KT = 235 * MiB;
constexpr size_t WS_VT = 303 * MiB;
constexpr size_t WS_ST = 371 * MiB;
constexpr size_t WS_HX = 371 * MiB;
constexpr size_t WS_WIN = 405 * MiB;
constexpr size_t WS_TMPCCH = 427 * MiB;
constexpr size_t WS_END = 507 * MiB;
constexpr size_t WS_YG = 203 * MiB;
constexpr size_t WS_MERGED = 107 * MiB;
constexpr size_t WS_HX2 = 303 * MiB;
constexpr size_t WS_WE13 = 371 * MiB;
constexpr size_t WS_WE2 = 435 * MiB;
constexpr size_t WS_ACT = 467 * MiB;
constexpr size_t WS_XS = 203 * MiB;
constexpr size_t WS_HID = 107 * MiB;
constexpr size_t WS_Y = 11 * MiB;
constexpr int CW_BAR = 4096;
constexpr int CW_CNT = 16384;

constexpr int NWAVES = 8, NTHREADS = 512;
constexpr int LDS_BYTES = 147456;
constexpr int LDS_MISC = 139264;

__device__ __forceinline__ float bf2f(bf16 v) { return __uint_as_float((unsigned)v << 16); }
__device__ __forceinline__ unsigned f2bf(float f) { unsigned u = __float_as_uint(f); return (u + 0x7fffu + ((u >> 16) & 1u)) >> 16; }
__device__ __forceinline__ unsigned pk2(float lo, float hi) { return f2bf(lo) | (f2bf(hi) << 16); }
__device__ __forceinline__ float siluf(float x) { return x / (1.f + __expf(-x)); }
__device__ __forceinline__ float sigm(float x) { return 1.f / (1.f + __expf(-x)); }
__device__ __forceinline__ float wave_sum(float v) {
#pragma unroll
    for (int o = 1; o < 64; o <<= 1) v += __shfl_xor(v, o);
    return v;
}
#define LDS_WAIT() asm volatile("s_waitcnt lgkmcnt(0)" ::: "memory")

#define XB_TMO      128
#define XB_XCNT(j)  (256  + 64 * (j))
#define XB_XSUB(j)  (1280 + 64 * (j))
#define XB_XGEN(j)  (2304 + 64 * (j))
#define XB_TOP      3328
#define XB_TOPGEN   3392
#define XCD_BAR_WORDS 3456
#define XB_SPIN_CAP (1u << 18)
__device__ __forceinline__ unsigned xb_ld(unsigned* p)              { return __hip_atomic_load(p, __ATOMIC_RELAXED, __HIP_MEMORY_SCOPE_AGENT); }
__device__ __forceinline__ unsigned xb_add(unsigned* p, unsigned v) { return __hip_atomic_fetch_add(p, v, __ATOMIC_RELAXED, __HIP_MEMORY_SCOPE_AGENT); }
__device__ __forceinline__ unsigned xb_xcc_id() { return (unsigned)__builtin_amdgcn_s_getreg((3 << 11) | 20) & 0xFu; }
#define XB_SPIN(cond, bar) do { unsigned _sp = 0; while (cond) { __builtin_amdgcn_s_sleep(1); \
    if ((++_sp & 255u) == 0u) { if (xb_ld(&(bar)[XB_TMO])) break; if (_sp > XB_SPIN_CAP) { atomicAdd(&(bar)[XB_TMO], 1u); break; } } } } while (0)
struct XcdBarrier { unsigned* bar; unsigned x; volatile LAS unsigned* st; };
__device__ __forceinline__ XcdBarrier xcd_barrier_post(unsigned* bar, volatile LAS unsigned* st) {
    XcdBarrier b; b.bar = bar; b.x = xb_xcc_id(); b.st = st;
    if (threadIdx.x == 0) (void)xb_add(&bar[XB_XCNT(b.x)], 1u);
    return b;
}
__device__ __forceinline__ void xcd_barrier_complete(unsigned* bar, unsigned x, unsigned& nloc, unsigned& nx) {
    const unsigned G = gridDim.x * gridDim.y * gridDim.z;
    unsigned sum, cnt, mine, sp = 0u;
    for (;;) {
        sum = 0u; cnt = 0u; mine = 0u;
#pragma unroll
        for (unsigned j = 0; j < 16; ++j) { const unsigned c = xb_ld(&bar[XB_XCNT(j)]); sum += c; cnt += (c > 0u) ? 1u : 0u; mine = (j == x) ? c : mine; }
        if (sum == G) break;
        __builtin_amdgcn_s_sleep(1);
        if ((++sp & 255u) == 0u) { if (xb_ld(&bar[XB_TMO])) break; if (sp > XB_SPIN_CAP) { atomicAdd(&bar[XB_TMO], 1u); break; } }
    }
    nloc = mine > 0u ? mine : 1u; nx = cnt > 0u ? cnt : 1u;
}
__device__ __forceinline__ void xcd_barrier(const XcdBarrier& b) {
    asm volatile("s_waitcnt vmcnt(0)" ::: "memory");
    __syncthreads();
    if (threadIdx.x == 0) {
        unsigned* bar = b.bar;
        __builtin_amdgcn_s_waitcnt(0);
        unsigned nloc = b.st[0], nx = b.st[1];
        if (nloc == 0u) { xcd_barrier_complete(bar, b.x, nloc, nx); b.st[0] = nloc; b.st[1] = nx; }
        const unsigned old = xb_add(&bar[XB_XSUB(b.x)], 1u);
        const unsigned gen = old / nloc;
        if (old + 1u == (gen + 1u) * nloc) {
            __builtin_amdgcn_fence(__ATOMIC_RELEASE, "agent");
            asm volatile("s_waitcnt vmcnt(0)" ::: "memory");
            const unsigned og = xb_add(&bar[XB_TOP], 1u);
            const unsigned tg = og / nx;
            if (og + 1u == (tg + 1u) * nx) xb_add(&bar[XB_TOPGEN], 1u);
            else XB_SPIN(xb_ld(&bar[XB_TOPGEN]) == tg, bar);
            __builtin_amdgcn_fence(__ATOMIC_ACQUIRE, "agent");
            xb_add(&bar[XB_XGEN(b.x)], 1u);
            asm volatile("s_waitcnt vmcnt(0)" ::: "memory");
        } else {
            XB_SPIN(xb_ld(&bar[XB_XGEN(b.x)]) == gen, bar);
            __builtin_amdgcn_fence(__ATOMIC_ACQUIRE, "agent");
            asm volatile("s_waitcnt vmcnt(0)" ::: "memory");
        }
    }
    __syncthreads();
}

struct Params { const float* in[22]; float* out; unsigned char* ws; };
enum { I_X = 0, I_C, I_CTX, I_CCTX, I_WMOD, I_BMOD, I_N1W, I_N2W, I_WIN, I_DECAY, I_GNW, I_WRETO, I_CONVW, I_WCONVO, I_WOUT, I_RGW, I_RGB, I_REW, I_REB, I_W13, I_W2, I_FNW };

struct Ctx {
    int tid, lane, wave, gw, ngw;
    LAS unsigned char* lds;
};

struct NSeg { const bf16* A; const bf16* B; int lda, ldb, K; };
template <int NS>
__device__ __forceinline__ void ngemm_acc(f32x4 (&acc)[4][4], const NSeg (&sg)[NS], int m0, int n0, int lane) {
    const int fr = lane & 15, fq = lane >> 4;
#pragma unroll
    for (int s = 0; s < NS; ++s) {
        const bf16* Ap = sg[s].A + (size_t)(m0 + fr) * sg[s].lda + 8 * fq;
        const bf16* Bp = sg[s].B + (size_t)(n0 + fr) * sg[s].ldb + 8 * fq;
        const size_t as = (size_t)16 * sg[s].lda, bs = (size_t)16 * sg[s].ldb;
        for (int k0 = 0; k0 < sg[s].K; k0 += 32) {
            bf16x8 a[4], b[4];
#pragma unroll
            for (int i = 0; i < 4; ++i) { a[i] = *(const bf16x8*)(Ap + i * as + k0); b[i] = *(const bf16x8*)(Bp + i * bs + k0); }
#pragma unroll
            for (int i = 0; i < 4; ++i)
#pragma unroll
                for (int j = 0; j < 4; ++j) acc[i][j] = __builtin_amdgcn_mfma_f32_16x16x32_bf16(b[j], a[i], acc[i][j], 0, 0, 0);
        }
    }
}
__device__ __forceinline__ void acc_zero(f32x4 (&acc)[4][4]) {
#pragma unroll
    for (int i = 0; i < 4; ++i)
#pragma unroll
        for (int j = 0; j < 4; ++j) acc[i][j] = (f32x4){0.f, 0.f, 0.f, 0.f};
}
template <class Epi>
__device__ __forceinline__ void ngemm(const Ctx& C, const bf16* A, int lda, const bf16* B, int ldb, int M, int N, int K, Epi epi) {
    const int tn = N / 64, nt = (M / 64) * tn;
    const int fr = C.lane & 15, fq = C.lane >> 4;
    for (int t = C.gw; t < nt; t += C.ngw) {
        const int m0 = (t / tn) * 64, n0 = (t % tn) * 64;
        f32x4 acc[4][4]; acc_zero(acc);
        const NSeg sg[1] = {{A, B, lda, ldb, K}};
        ngemm_acc<1>(acc, sg, m0, n0, C.lane);
#pragma unroll
        for (int i = 0; i < 4; ++i)
#pragma unroll
            for (int j = 0; j < 4; ++j) epi(m0 + 16 * i + fr, n0 + 16 * j + 4 * fq, acc[i][j]);
    }
}
__device__ __forceinline__ void st_bf4(bf16* p, f32x4 v) { v2u w; w.x = pk2(v[0], v[1]); w.y = pk2(v[2], v[3]); *(v2u*)p = w; }
__device__ __forceinline__ f32x4 ld_bf4(const bf16* p) { const v2u w = *(const v2u*)p; return (f32x4){__uint_as_float(w.x << 16), __uint_as_float(w.x & 0xffff0000u), __uint_as_float(w.y << 16), __uint_as_float(w.y & 0xffff0000u)}; }

__device__ __forceinline__ void transpose_item(const float* W, int ldw, int k0, int srccol, bf16* dst0, int dpitch, LAS float* scr, int lane) {
#pragma unroll 8
    for (int i = 0; i < 32; ++i) { const int kk = 2 * i + (lane >> 5); scr[kk * 33 + (lane & 31)] = W[(size_t)(k0 + kk) * ldw + srccol]; }
    LDS_WAIT(); asm volatile("" ::: "memory");
    const int c = lane & 7;
#pragma unroll
    for (int j = 0; j < 4; ++j) { const int n = (lane >> 3) + 8 * j; const LAS float* s = scr + (8 * c) * 33 + n;
        v4u o; o.x = pk2(s[0 * 33], s[1 * 33]); o.y = pk2(s[2 * 33], s[3 * 33]); o.z = pk2(s[4 * 33], s[5 * 33]); o.w = pk2(s[6 * 33], s[7 * 33]);
        *(v4u*)(dst0 + (size_t)n * dpitch + 8 * c) = o; }
    LDS_WAIT(); asm volatile("" ::: "memory");
}
__device__ __forceinline__ int win_src(int rho) {
    if (rho < R_V) {
        const int base = rho < R_K ? OFF_Q : OFF_K, r = rho & 1023, h = r >> 8, p = r & 255;
        const int half = p >> 7, pp = p & 127, i = pp >> 1, s = pp & 1;
        return base + h * 256 + half * 128 + s * 64 + i;
    }
    if (rho < R_CCH) return rho;
    if (rho < R_GATE) { const int r = rho - R_CCH, g = r >> 8, w = r & 255; return w < 128 ? OFF_CC + g * 128 + w : OFF_CH + g * 128 + (w - 128); }
    return rho;
}

__global__ void __launch_bounds__(NTHREADS, 2) fwd_kernel(Params P) {
    extern __shared__ __attribute__((aligned(16))) unsigned char lds_raw[];
    Ctx C;
    C.lds = (LAS unsigned char*)lds_raw;
    C.tid = threadIdx.x; C.lane = C.tid & 63; C.wave = __builtin_amdgcn_readfirstlane(C.tid >> 6);
    C.gw = blockIdx.x * NWAVES + C.wave; C.ngw = gridDim.x * NWAVES;
    const int lane = C.lane, tid = C.tid;
    unsigned char* ws = P.ws;
    unsigned* ctl = (unsigned*)(ws + WS_CTL);
    volatile LAS unsigned* MISC = (volatile LAS unsigned*)(C.lds + LDS_MISC);
    if (tid < 64) MISC[tid] = 0u;
    __syncthreads();
    XcdBarrier bar = xcd_barrier_post(ctl + CW_BAR, MISC + 8);
#define GRID_BAR() xcd_barrier(bar)

    float* MOD = (float*)(ws + WS_SMALL + SM_MOD);
    float* ROPE_C = (float*)(ws + WS_SMALL + SM_ROPE); float* ROPE_S = ROPE_C + 4096;
    float* DEC = (float*)(ws + WS_SMALL + SM_DEC);
    int* TOKE = (int*)(ws + WS_SMALL + SM_TOKE); int* TOKP = (int*)(ws + WS_SMALL + SM_TOKP); float* TOKW = (float*)(ws + WS_SMALL + SM_TOKW); int* TOKS = (int*)(ws + WS_SMALL + SM_TOKS);
    float* SLOTW = (float*)(ws + WS_SMALL + SM_SLOTW);
    bf16* WCAT = (bf16*)(ws + WS_WCAT); bf16* WOUT = (bf16*)(ws + WS_WOUT);
    bf16* CBU = (bf16*)(ws + WS_CBU); bf16* SG = (bf16*)(ws + WS_SG); bf16* ACAT = (bf16*)(ws + WS_ACAT); bf16* KB = (bf16*)(ws + WS_KB);
    bf16* KTF = (bf16*)(ws + WS_KT); bf16* KTB = KTF + (size_t)QKW * TP; bf16* VT = (bf16*)(ws + WS_VT);
    bf16* STF = (bf16*)(ws + WS_ST); bf16* STB = STF + (size_t)VW * TP;
    bf16* HX = (bf16*)(ws + WS_HX); bf16* WIN = (bf16*)(ws + WS_WIN); bf16* TMPCCH = (bf16*)(ws + WS_TMPCCH);
    bf16* YG = (bf16*)(ws + WS_YG); bf16* MERGED = (bf16*)(ws + WS_MERGED); bf16* HX2 = (bf16*)(ws + WS_HX2);
    bf16* WE13 = (bf16*)(ws + WS_WE13); bf16* WE2 = (bf16*)(ws + WS_WE2); bf16* ACT = (bf16*)(ws + WS_ACT); bf16* XS = (bf16*)(ws + WS_XS);
    bf16* HID = (bf16*)(ws + WS_HID); bf16* YB = (bf16*)(ws + WS_Y);
    bf16* G1 = (bf16*)P.out; bf16* G2 = G1 + (size_t)T * DM;
    float* X1 = P.out;
    LAS float* scr = (LAS float*)(C.lds + C.wave * 16384);

    {
        const float* wmod = P.in[I_WMOD];
        LAS float* red = (LAS float*)(C.lds + 131072);
        for (int it = blockIdx.x; it < 192; it += gridDim.x) {
            const int cg = lane & 7, kr = lane >> 3;
            f32x4 a[5];
#pragma unroll
            for (int r = 0; r < 5; ++r) a[r] = (f32x4){0.f, 0.f, 0.f, 0.f};
            for (int i = 0; i < 16; ++i) {
                const int k = C.wave * 128 + i * 8 + kr;
                const f32x4 w4 = *(const f32x4*)(wmod + (size_t)k * 6144 + it * 32 + cg * 4);
#pragma unroll
                for (int r = 0; r < 5; ++r) { const float cv = r < 4 ? P.in[I_C][r * DM + k] : P.in[I_CCTX][k]; a[r] += w4 * siluf(cv); }
            }
#pragma unroll
            for (int r = 0; r < 5; ++r)
#pragma unroll
                for (int e = 0; e < 4; ++e) { float v = a[r][e]; v += __shfl_xor(v, 8); v += __shfl_xor(v, 16); v += __shfl_xor(v, 32); a[r][e] = v; }
            if (kr == 0) {
#pragma unroll
                for (int r = 0; r < 5; ++r)
#pragma unroll
                    for (int e = 0; e < 4; ++e) red[(C.wave * 5 + r) * 32 + cg * 4 + e] = a[r][e];
            }
            __syncthreads();
            if (tid < 160) { const int r = tid >> 5, col = tid & 31; float s = 0.f;
#pragma unroll
                for (int w = 0; w < 8; ++w) s += red[(w * 5 + r) * 32 + col];
                MOD[r * 6144 + it * 32 + col] = s + P.in[I_BMOD][it * 32 + col]; }
            __syncthreads();
        }
        for (int it = C.gw; it < 16 * (PROJ_W / 32); it += C.ngw) {
            const int kb = it & 15, rb = it >> 4;
            transpose_item(P.in[I_WIN], PROJ_W, kb * 64, win_src(rb * 32 + (lane & 31)), WIN + (size_t)(rb * 32) * DM + kb * 64, DM, scr, lane);
        }
        if (blockIdx.x == gridDim.x - 1) {
            for (int i = tid; i < 4096; i += NTHREADS) { const int pos = i >> 6, f = i & 63;
                const float inv = powf(10000.0f, -(float)f / 64.0f), ang = (float)pos * inv;
                ROPE_C[i] = cosf(ang); ROPE_S[i] = sinf(ang); }
            if (tid < 8) { const float ld = P.in[I_DECAY][tid]; DEC[tid] = log1pf(-expf(ld)) * 1.4426950408889634f; }
        }
    }
    GRID_BAR();
    {
        for (int row = C.gw; row < TP; row += C.ngw) {
            const bool isx = row < T; const int mr = isx ? row / SEQ : 4;
            const float* xr = isx ? P.in[I_X] + (size_t)row * DM : P.in[I_CTX] + (size_t)(row - T) * DM;
            f32x4 v[4]; float s2 = 0.f;
#pragma unroll
            for (int j = 0; j < 4; ++j) { v[j] = *(const f32x4*)(xr + 256 * j + 4 * lane); s2 += v[j][0] * v[j][0] + v[j][1] * v[j][1] + v[j][2] * v[j][2] + v[j][3] * v[j][3]; }
            const float rstd = rsqrtf(wave_sum(s2) * (1.f / DM) + 1e-6f);
#pragma unroll
            for (int j = 0; j < 4; ++j) { const int c = 256 * j + 4 * lane;
                const f32x4 w = *(const f32x4*)(P.in[I_N1W] + c), sh = *(const f32x4*)(MOD + mr * 6144 + c), sc = *(const f32x4*)(MOD + mr * 6144 + 1024 + c);
                const f32x4 o = (v[j] * rstd * w) * (sc + 1.f) + sh;
                st_bf4(HX + (size_t)row * DM + c, o); }
        }
        for (int it = C.gw; it < (16 + 32 + 16) * 32; it += C.ngw) {
            const int rb = it & 31; int kb = it >> 5;
            if (kb < 16) transpose_item(P.in[I_WCONVO], DM, kb * 64, rb * 32 + (lane & 31), WCAT + (size_t)(rb * 32) * 3072 + kb * 64, 3072, scr, lane);
            else if (kb < 48) { kb -= 16; transpose_item(P.in[I_WRETO], DM, kb * 64, rb * 32 + (lane & 31), WCAT + (size_t)(rb * 32) * 3072 + 1024 + kb * 64, 3072, scr, lane); }
            else { kb -= 48; transpose_item(P.in[I_WOUT], DM, kb * 64, rb * 32 + (lane & 31), WOUT + (size_t)(rb * 32) * DM + kb * 64, DM, scr, lane); }
        }
    }
    GRID_BAR();
    {
        auto rope4 = [&](f32x4 v, int p, int n) -> f32x4 {
            const int half = p >> 7, i0 = (p & 127) >> 1, pos = half ? (n & 63) : (n >> 6);
            const float c0 = ROPE_C[pos * 64 + i0], s0 = ROPE_S[pos * 64 + i0], c1 = ROPE_C[pos * 64 + i0 + 1], s1 = ROPE_S[pos * 64 + i0 + 1];
            return (f32x4){v[0] * c0 - v[1] * s0, v[0] * s0 + v[1] * c0, v[2] * c1 - v[3] * s1, v[2] * s1 + v[3] * c1};
        };
        ngemm(C, HX, DM, WIN + (size_t)R_Q * DM, DM, T, QKW, DM, [&](int t, int col, f32x4 v) {
            const int h = col >> 8, p = col & 255, n = t & (SEQ - 1), i = n & (CH - 1);
            const f32x4 o = rope4(v, p, n);
            const float xf = exp2f(DEC[h] * (float)(i + 1)), xb = exp2f(DEC[4 + h] * (float)(CH - i));
            bf16* dst = ACAT + ((size_t)h * T + t) * 768 + p;
            st_bf4(dst + 256, o * xf); st_bf4(dst + 512, o * xb);
        });
        ngemm(C, HX, DM, WIN + (size_t)R_K * DM, DM, T, QKW, DM, [&](int t, int col, f32x4 v) {
            const int p = col & 255, n = t & (SEQ - 1);
            st_bf4(KB + (size_t)t * QKW + col, rope4(v, p, n) * 0.0625f);
        });
        ngemm(C, WIN + (size_t)R_K * DM, DM, HX, DM, QKW, TP, DM, [&](int row, int tc, f32x4 v) {
            const int h = row >> 8, p = row & 255;
            f32x4 o = v;
            f32x4 pr; pr[0] = __shfl_xor(v[0], 1); pr[1] = __shfl_xor(v[1], 1); pr[2] = __shfl_xor(v[2], 1); pr[3] = __shfl_xor(v[3], 1);
            int j0;
            if (tc < T) {
                const int n0 = tc & (SEQ - 1), half = p >> 7, fi = (p & 127) >> 1;
#pragma unroll
                for (int e = 0; e < 4; ++e) { const int n = n0 + e, pos = half ? (n & 63) : (n >> 6);
                    const float cs = ROPE_C[pos * 64 + fi], sn = ROPE_S[pos * 64 + fi];
                    o[e] = (p & 1) ? (pr[e] * sn + v[e] * cs) : (v[e] * cs - pr[e] * sn); }
                j0 = n0 & (CH - 1);
            } else j0 = (tc - T) & (CTXL - 1);
            f32x4 of, ob;
#pragma unroll
            for (int e = 0; e < 4; ++e) { const float kk = o[e] * 0.0625f; of[e] = kk * exp2f(DEC[h] * (float)(CH - 1 - (j0 + e))); ob[e] = kk * exp2f(DEC[4 + h] * (float)(j0 + e)); }
            st_bf4(KTF + (size_t)row * TP + tc, of); st_bf4(KTB + (size_t)row * TP + tc, ob);
        });
        ngemm(C, WIN + (size_t)R_V * DM, DM, HX, DM, VW, TP, DM, [&](int row, int tc, f32x4 v) { st_bf4(VT + (size_t)row * TP + tc, v); });
        ngemm(C, HX, DM, WIN + (size_t)R_G * DM, DM, T, VW, DM, [&](int t, int col, f32x4 v) {
            st_bf4(SG + (size_t)t * VW + col, (f32x4){siluf(v[0]), siluf(v[1]), siluf(v[2]), siluf(v[3])}); });
        ngemm(C, HX, DM, WIN + (size_t)R_CB * DM, DM, T, DM, DM, [&](int t, int col, f32x4 v) { st_bf4(CBU + (size_t)t * DM + col, v); });
        ngemm(C, HX, DM, WIN + (size_t)R_CCH * DM, DM, T, 2048, DM, [&](int t, int col, f32x4 v) {
            const int g = col >> 8, w = col & 255, isch = w >> 7, chn = g * 128 + (w & 127);
            st_bf4(TMPCCH + (size_t)t * 2048 + isch * 1024 + chn, v); });
        ngemm(C, HX, DM, WIN + (size_t)R_GATE * DM, DM, T, 2048, DM, [&](int t, int col, f32x4 v) {
            const f32x4 o = (f32x4){sigm(v[0]), sigm(v[1]), sigm(v[2]), sigm(v[3])};
            if (col < DM) st_bf4(G1 + (size_t)t * DM + col, o); else st_bf4(G2 + (size_t)t * DM + col - DM, o); });
    }
    GRID_BAR();
    {
        const float* cw = P.in[I_CONVW];
        for (int it = C.gw * 64 + lane; it < T * (DM / 4); it += C.ngw * 64) {
            const int t = it >> 8, c = (it & 255) * 4, colp = t & 63;
            f32x4 u = (f32x4){0.f, 0.f, 0.f, 0.f};
#pragma unroll
            for (int j = 0; j < 3; ++j) { const int cp = colp + j - 1;
                if (cp >= 0 && cp < 64) { const size_t tt = (size_t)(t + j - 1) * 2048;
                    u += ld_bf4(TMPCCH + tt + c) * ld_bf4(TMPCCH + tt + 1024 + c) * *(const f32x4*)(cw + j * DM + c); } }
            bf16* d = CBU + (size_t)t * DM + c;
            st_bf4(d, ld_bf4(d) * u);
        }
    }
    GRID_BAR();
    {
        for (int t = C.gw; t < NB * NCH * NH * 16; t += C.ngw) {
            const int prob = t >> 4, sub = t & 15, h = prob & 3, bc = prob >> 2, t0 = bc * CH;
            const int m0 = (sub >> 2) * 64, n0 = (sub & 3) * 64, fr = lane & 15, fq = lane >> 4;
            f32x4 acc[4][4]; acc_zero(acc);
            bf16* Ah = ACAT + ((size_t)h * T + t0) * 768;
            const NSeg sg[1] = {{Ah + 256, KB + (size_t)t0 * QKW + h * DK, 768, QKW, DK}};
            ngemm_acc<1>(acc, sg, m0, n0, lane);
            const float lf = DEC[h], lb = DEC[4 + h];
#pragma unroll
            for (int i = 0; i < 4; ++i)
#pragma unroll
                for (int j = 0; j < 4; ++j) { const int ii = m0 + 16 * i + fr, jj = n0 + 16 * j + 4 * fq; f32x4 o;
#pragma unroll
                    for (int e = 0; e < 4; ++e) { const int jc = jj + e;
                        const float m = jc <= ii ? exp2f(-lf * (float)(jc + 1)) : exp2f(lb * (float)(jc - ii) - lf * (float)(ii + 1));
                        o[e] = acc[i][j][e] * m; }
                    st_bf4(Ah + (size_t)ii * 768 + jj, o); }
        }
        for (int t = C.gw; t < NB * NH * 2 * 32; t += C.ngw) {
            const int tile = t & 31, dir = (t >> 5) & 1, h = (t >> 6) & 3, b = t >> 8;
            const int m0 = (tile >> 2) * 64, n0 = (tile & 3) * 64, fr = lane & 15, fq = lane >> 4;
            const bf16* Av = VT + (size_t)(h * DV) * TP; const bf16* Bk = (dir ? KTB : KTF) + (size_t)(h * DK) * TP;
            bf16* ST = (dir ? STB : STF) + (size_t)(h * DV) * TP;
            const float dec = exp2f(DEC[dir * 4 + h] * (float)CH);
            f32x4 acc[4][4]; acc_zero(acc);
            for (int s = 0; s < NCH; ++s) {
                const int tc0 = s == 0 ? T + b * CTXL : b * SEQ + (dir ? (NCH - s) : (s - 1)) * CH;
                const NSeg sg[1] = {{Av + tc0, Bk + tc0, TP, TP, CH}};
                ngemm_acc<1>(acc, sg, m0, n0, lane);
                const int dc = b * SEQ + (dir ? (NCH - 1 - s) : s) * CH;
#pragma unroll
                for (int i = 0; i < 4; ++i)
#pragma unroll
                    for (int j = 0; j < 4; ++j) { st_bf4(ST + (size_t)(m0 + 16 * i + fr) * TP + dc + n0 + 16 * j + 4 * fq, acc[i][j]); acc[i][j] = acc[i][j] * dec; }
            }
        }
    }
    GRID_BAR();
    {
        for (int t = C.gw; t < NB * NCH * NH * 32; t += C.ngw) {
            const int prob = t >> 5, sub = t & 31, h = prob & 3, bc = prob >> 2, t0 = bc * CH;
            const int m0 = (sub >> 3) * 64, n0 = (sub & 7) * 64, fr = lane & 15, fq = lane >> 4;
            f32x4 acc[4][4]; acc_zero(acc);
            const bf16* Ah = ACAT + ((size_t)h * T + t0) * 768;
            const size_t bo = (size_t)(h * DV) * TP + t0;
            const NSeg sg[3] = {{Ah, VT + bo, 768, TP, CH}, {Ah + 256, STF + bo, 768, TP, DK}, {Ah + 512, STB + bo, 768, TP, DK}};
            ngemm_acc<3>(acc, sg, m0, n0, lane);
#pragma unroll
            for (int i = 0; i < 4; ++i)
#pragma unroll
                for (int j = 0; j < 4; ++j) st_bf4(YG + (size_t)(t0 + m0 + 16 * i + fr) * VW + h * DV + n0 + 16 * j + 4 * fq, acc[i][j]);
        }
    }
    GRID_BAR();
    {
        const float* gnw = P.in[I_GNW];
        for (int r = C.gw; r < T * NH; r += C.ngw) {
            const int t = r >> 2, h = r & 3; bf16* yp = YG + (size_t)t * VW + h * DV + lane * 8;
            const f32x4 a = ld_bf4(yp), b = ld_bf4(yp + 4);
            const float mu = wave_sum((a[0] + a[1]) + (a[2] + a[3]) + (b[0] + b[1]) + (b[2] + b[3])) * (1.f / DV);
            const f32x4 da = a - mu, db = b - mu;
            const float var = wave_sum(da[0] * da[0] + da[1] * da[1] + da[2] * da[2] + da[3] * da[3] + db[0] * db[0] + db[1] * db[1] + db[2] * db[2] + db[3] * db[3]) * (1.f / DV);
            const float rstd = rsqrtf(var + 1e-5f);
            const float* gw = gnw + h * DV + lane * 8; const bf16* sg = SG + (size_t)t * VW + h * DV + lane * 8;
            st_bf4(yp, da * rstd * *(const f32x4*)gw * ld_bf4(sg));
            st_bf4(yp + 4, db * rstd * *(const f32x4*)(gw + 4) * ld_bf4(sg + 4));
        }
    }
    GRID_BAR();
    ngemm(C, CBU, DM, WCAT, 3072, T, DM, DM, [&](int t, int col, f32x4 v) { const size_t o = (size_t)t * DM + col; st_bf4(MERGED + o, v * ld_bf4(G2 + o)); });
    GRID_BAR();
    ngemm(C, YG, VW, WCAT + 1024, 3072, T, DM, VW, [&](int t, int col, f32x4 v) { const size_t o = (size_t)t * DM + col; st_bf4(MERGED + o, v * ld_bf4(G1 + o) + ld_bf4(MERGED + o)); });
    GRID_BAR();
    ngemm(C, MERGED, DM, WOUT, DM, T, DM, DM, [&](int t, int col, f32x4 v) {
        const size_t o = (size_t)t * DM + col; const int b = t / SEQ;
        *(f32x4*)(X1 + o) = *(const f32x4*)(P.in[I_X] + o) + *(const f32x4*)(MOD + b * 6144 + 2048 + col) * v; });
    GRID_BAR();
    {
        for (int row = C.gw; row < T; row += C.ngw) {
            const int mr = row / SEQ; const float* xr = X1 + (size_t)row * DM;
            f32x4 v[4]; float s2 = 0.f;
#pragma unroll
            for (int j = 0; j < 4; ++j) { v[j] = *(const f32x4*)(xr + 256 * j + 4 * lane); s2 += v[j][0] * v[j][0] + v[j][1] * v[j][1] + v[j][2] * v[j][2] + v[j][3] * v[j][3]; }
            const float rstd = rsqrtf(wave_sum(s2) * (1.f / DM) + 1e-6f);
#pragma unroll
            for (int j = 0; j < 4; ++j) { const int c = 256 * j + 4 * lane;
                const f32x4 w = *(const f32x4*)(P.in[I_N2W] + c), sh = *(const f32x4*)(MOD + mr * 6144 + 3072 + c), sc = *(const f32x4*)(MOD + mr * 6144 + 4096 + c);
                st_bf4(HX2 + (size_t)row * DM + c, (v[j] * rstd * w) * (sc + 1.f) + sh); }
        }
        for (int it = C.gw; it < NE * (16 * 32 + 8 * 32); it += C.ngw) {
            const int e = it / 768, r = it % 768;
            if (r < 512) { const int kb = r & 15, rb = r >> 4, rho = rb * 32 + (lane & 31), g = rho >> 8, w = rho & 255;
                transpose_item(P.in[I_W13] + (size_t)e * DM * 1024, 1024, kb * 64, w < 128 ? g * 128 + w : 512 + g * 128 + (w - 128), WE13 + ((size_t)e * 1024 + rb * 32) * DM + kb * 64, DM, scr, lane); }
            else { const int r2 = r - 512, kb = r2 & 7, rb = r2 >> 3;
                transpose_item(P.in[I_W2] + (size_t)e * EH * DM, DM, kb * 64, rb * 32 + (lane & 31), WE2 + ((size_t)e * DM + rb * 32) * EH + kb * 64, EH, scr, lane); }
        }
    }
    GRID_BAR();
    {
        const float* rgw = P.in[I_RGW]; const float* rew = P.in[I_REW];
        for (int t = C.gw; t < T; t += C.ngw) {
            const bf16* xr = HX2 + (size_t)t * DM;
            float acc = 0.f;
            if (lane < 36) {
                const float* wp = lane < 4 ? rgw + lane : rew + (lane - 4); const int ldw = lane < 4 ? 4 : 32;
                for (int k = 0; k < DM; k += 4) { const f32x4 xv = ld_bf4(xr + k);
                    acc += xv[0] * wp[(size_t)k * ldw] + xv[1] * wp[(size_t)(k + 1) * ldw] + xv[2] * wp[(size_t)(k + 2) * ldw] + xv[3] * wp[(size_t)(k + 3) * ldw]; }
                acc += lane < 4 ? P.in[I_RGB][lane] : P.in[I_REB][lane - 4];
            }
            float gl[4];
#pragma unroll
            for (int g = 0; g < 4; ++g) gl[g] = __shfl(acc, g);
            int gi = 0; float gm = gl[0];
#pragma unroll
            for (int g = 1; g < 4; ++g) if (gl[g] > gm) { gm = gl[g]; gi = g; }
            float gs = 0.f;
#pragma unroll
            for (int g = 0; g < 4; ++g) gs += __expf(gl[g] - gm);
            const float gwt = 1.f / gs;
            float el[8];
#pragma unroll
            for (int j = 0; j < 8; ++j) el[j] = __shfl(acc, 4 + gi * 8 + j);
            int i1 = 0; float m1 = el[0];
#pragma unroll
            for (int j = 1; j < 8; ++j) if (el[j] > m1) { m1 = el[j]; i1 = j; }
            int i2 = -1; float m2 = -3.0e38f;
#pragma unroll
            for (int j = 0; j < 8; ++j) if (j != i1 && el[j] > m2) { m2 = el[j]; i2 = j; }
            const float e2 = __expf(m2 - m1), w1 = 1.f / (1.f + e2), w2 = e2 * w1;
            if (lane < 2) {
                const int e = gi * 8 + (lane == 0 ? i1 : i2);
                const int pos = (int)atomicAdd(ctl + CW_CNT + e, 1u);
                TOKE[t * 2 + lane] = e; TOKP[t * 2 + lane] = pos; TOKW[t * 2 + lane] = gwt * (lane == 0 ? w1 : w2);
            }
        }
    }
    GRID_BAR();
    int eoff[NE + 1];
    {
        int run = 0;
#pragma unroll
        for (int e = 0; e < NE; ++e) { eoff[e] = run; const int c = (int)__hip_atomic_load(ctl + CW_CNT + e, __ATOMIC_RELAXED, __HIP_MEMORY_SCOPE_AGENT); run += (c + 255) & ~255; }
        eoff[NE] = run;
    }
    const int nslot = eoff[NE];
    {
        for (int r = C.gw; r < 2 * T; r += C.ngw) {
            const int t = r >> 1, e = TOKE[r], pos = TOKP[r];
            int off = 0;
#pragma unroll
            for (int q = 0; q < NE; ++q) off = (q == e) ? eoff[q] : off;
            const int slot = off + pos;
            if (lane == 0) { TOKS[r] = slot; SLOTW[slot] = TOKW[r]; }
            const v4u* src = (const v4u*)(HX2 + (size_t)t * DM); v4u* dst = (v4u*)(XS + (size_t)slot * DM);
            dst[lane] = src[lane]; dst[lane + 64] = src[lane + 64];
        }
#pragma unroll 1
        for (int e = 0; e < NE; ++e) {
            int off = 0, nxt = 0;
#pragma unroll
            for (int q = 0; q < NE; ++q) { off = (q == e) ? eoff[q] : off; nxt = (q == e) ? eoff[q + 1] : nxt; }
            const int c = (int)__hip_atomic_load(ctl + CW_CNT + e, __ATOMIC_RELAXED, __HIP_MEMORY_SCOPE_AGENT);
            for (int r = off + c + C.gw; r < nxt; r += C.ngw) { v4u* dst = (v4u*)(XS + (size_t)r * DM); const v4u z = (v4u){0u, 0u, 0u, 0u}; dst[lane] = z; dst[lane + 64] = z; if (lane == 0) SLOTW[r] = 0.f; }
        }
    }
    GRID_BAR();
    {
        const int tn = 1024 / 64, nt = (nslot / 64) * tn, fr = lane & 15, fq = lane >> 4;
        for (int t = C.gw; t < nt; t += C.ngw) {
            const int m0 = (t / tn) * 64, n0 = (t % tn) * 64;
            int e = 0;
#pragma unroll
            for (int q = 1; q < NE; ++q) e += (m0 >= eoff[q]) ? 1 : 0;
            f32x4 acc[4][4]; acc_zero(acc);
            const NSeg sg[1] = {{XS, WE13 + (size_t)e * 1024 * DM, DM, DM, DM}};
            ngemm_acc<1>(acc, sg, m0, n0, lane);
#pragma unroll
            for (int i = 0; i < 4; ++i)
#pragma unroll
                for (int j = 0; j < 4; ++j) st_bf4(HID + (size_t)(m0 + 16 * i + fr) * 1024 + n0 + 16 * j + 4 * fq, acc[i][j]);
        }
    }
    GRID_BAR();
    {
        for (int it = C.gw * 64 + lane; it < nslot * (EH / 4); it += C.ngw * 64) {
            const int s = it >> 7, c = (it & 127) * 4, g = c >> 7, w = c & 127;
            const f32x4 h1 = ld_bf4(HID + (size_t)s * 1024 + g * 256 + w), h2 = ld_bf4(HID + (size_t)s * 1024 + g * 256 + 128 + w);
            st_bf4(ACT + (size_t)s * EH + c, (f32x4){siluf(h1[0]) * h2[0], siluf(h1[1]) * h2[1], siluf(h1[2]) * h2[2], siluf(h1[3]) * h2[3]});
        }
    }
    GRID_BAR();
    {
        const int tn = DM / 64, nt = (nslot / 64) * tn, fr = lane & 15, fq = lane >> 4;
        for (int t = C.gw; t < nt; t += C.ngw) {
            const int m0 = (t / tn) * 64, n0 = (t % tn) * 64;
            int e = 0;
#pragma unroll
            for (int q = 1; q < NE; ++q) e += (m0 >= eoff[q]) ? 1 : 0;
            f32x4 acc[4][4]; acc_zero(acc);
            const NSeg sg[1] = {{ACT, WE2 + (size_t)e * DM * EH, EH, EH, EH}};
            ngemm_acc<1>(acc, sg, m0, n0, lane);
#pragma unroll
            for (int i = 0; i < 4; ++i) { const int row = m0 + 16 * i + fr; const float cwt = SLOTW[row];
#pragma unroll
                for (int j = 0; j < 4; ++j) st_bf4(YB + (size_t)row * DM + n0 + 16 * j + 4 * fq, acc[i][j] * cwt); }
        }
    }
    GRID_BAR();
    {
        for (int row = C.gw; row < T; row += C.ngw) {
            const int mr = row / SEQ; float* xr = X1 + (size_t)row * DM;
            const int s0 = TOKS[row * 2], s1 = TOKS[row * 2 + 1];
            f32x4 v[4]; float s2 = 0.f;
#pragma unroll
            for (int j = 0; j < 4; ++j) { const int c = 256 * j + 4 * lane;
                const f32x4 y = ld_bf4(YB + (size_t)s0 * DM + c) + ld_bf4(YB + (size_t)s1 * DM + c);
                v[j] = *(const f32x4*)(xr + c) + *(const f32x4*)(MOD + mr * 6144 + 5120 + c) * y;
                s2 += v[j][0] * v[j][0] + v[j][1] * v[j][1] + v[j][2] * v[j][2] + v[j][3] * v[j][3]; }
            const float rstd = rsqrtf(wave_sum(s2) * (1.f / DM) + 1e-6f);
#pragma unroll
            for (int j = 0; j < 4; ++j) { const int c = 256 * j + 4 * lane; *(f32x4*)(xr + c) = v[j] * rstd * *(const f32x4*)(P.in[I_FNW] + c); }
        }
    }
}

extern "C" void kernel_launch(void* const* d_in, const int* in_sizes, int n_in, void* d_out, int out_size, void* d_ws, size_t ws_size, hipStream_t stream) {
    static int grid = 0;
    if (grid == 0) {
        if (n_in != 22 || out_size != T * DM || ws_size < WS_END) { fprintf(stderr, "kernel_launch: unexpected problem (n_in %d, out %d, ws %zu, need %zu)\n", n_in, out_size, ws_size, (size_t)WS_END); grid = -1; return; }
        int dev = 0, cus = 0, per_cu = 0;
        if (hipGetDevice(&dev) != hipSuccess || hipDeviceGetAttribute(&cus, hipDeviceAttributeMultiprocessorCount, dev) != hipSuccess) { grid = -1; return; }
        if (hipFuncSetAttribute((const void*)fwd_kernel, hipFuncAttributeMaxDynamicSharedMemorySize, LDS_BYTES) != hipSuccess) { fprintf(stderr, "kernel_launch: hipFuncSetAttribute failed\n"); grid = -1; return; }
        if (hipOccupancyMaxActiveBlocksPerMultiprocessor(&per_cu, (const void*)fwd_kernel, NTHREADS, LDS_BYTES) != hipSuccess || per_cu < 1) { fprintf(stderr, "kernel_launch: occupancy query reports %d\n", per_cu); per_cu = 1; }
        (void)hipGetLastError();
        grid = cus;
    }
    if (grid < 0) return;
    (void)hipMemsetAsync((char*)d_ws + WS_CTL, 0, 1 * MiB, stream);
    Params p{};
    for (int i = 0; i < 22; ++i) p.in[i] = (const float*)d_in[i];
    p.out = (float*)d_out; p.ws = (unsigned char*)d_ws;
    hipLaunchKernelGGL(fwd_kernel, dim3(grid), dim3(NTHREADS), LDS_BYTES, stream, p);
}
```

```cpp
#include <hip/hip_runtime.h>
#include <cstdio>
#include <cstdint>

#define GAS __attribute__((address_space(1)))
#define LAS __attribute__((address_space(3)))
typedef unsigned short bf16;
typedef short bf16x8 __attribute__((ext_vector_type(8)));
typedef float f32x4 __attribute__((ext_vector_type(4)));
typedef unsigned v4u __attribute__((ext_vector_type(4)));
typedef unsigned v2u __attribute__((ext_vector_type(2)));

constexpr int DM = 1024, NB = 4, SEQ = 4096, T = NB * SEQ, CTXL = 256, TCX = NB * CTXL, TP = T + TCX;
constexpr int NH = 4, DK = 256, DV = 512, QKW = NH * DK, VW = NH * DV;
constexpr int CH = 256, NCH = SEQ / CH;
constexpr int PROJ_W = 11264;
constexpr int OFF_Q = 0, OFF_K = 1024, OFF_V = 2048, OFF_G = 4096, OFF_CB = 6144, OFF_CC = 7168, OFF_CH = 8192, OFF_GATE = 9216;
constexpr int R_Q = 0, R_K = 1024, R_V = 2048, R_G = 4096, R_CB = 6144, R_CCH = 7168, R_GATE = 9216;
constexpr int NE = 32, EH = 512;
constexpr int MAXSLOT = 2 * T + NE * 256;

constexpr size_t MiB = 1u << 20;
constexpr size_t WS_CTL = 0;
constexpr size_t WS_SMALL = 1 * MiB;
constexpr size_t SM_MOD = 0;
constexpr size_t SM_ROPE = 128 * 1024;
constexpr size_t SM_DEC = 192 * 1024;
constexpr size_t SM_TOKE = 256 * 1024;
constexpr size_t SM_TOKP = 384 * 1024;
constexpr size_t SM_TOKW = 512 * 1024;
constexpr size_t SM_TOKS = 640 * 1024;
constexpr size_t SM_SLOTW = 768 * 1024;
constexpr size_t WS_WCAT = 2 * MiB;
constexpr size_t WS_WOUT = 8 * MiB;
constexpr size_t WS_WR = 10 * MiB;
constexpr size_t WS_CBU = 11 * MiB;
constexpr size_t WS_SG = 43 * MiB;
constexpr size_t WS_ACAT = 107 * MiB;
constexpr size_t WS_KB = 203 * MiB;
constexpr size_t WS_KT = 235 * MiB;
constexpr size_t WS_VT = 303 * MiB;
constexpr size_t WS_ST = 371 * MiB;
constexpr size_t WS_HX = 371 * MiB;
constexpr size_t WS_WIN = 405 * MiB;
constexpr size_t WS_TMPCCH = 427 * MiB;
constexpr size_t WS_END = 507 * MiB;
constexpr size_t WS_YG = 203 * MiB;
constexpr size_t WS_MERGED = 107 * MiB;
constexpr size_t WS_HX2 = 303 * MiB;
constexpr size_t WS_WE13 = 371 * MiB;
constexpr size_t WS_WE2 = 435 * MiB;
constexpr size_t WS_ACT = 467 * MiB;
constexpr size_t WS_XS = 203 * MiB;
constexpr size_t WS_HID = 107 * MiB;
constexpr size_t WS_Y = 11 * MiB;
constexpr int CW_BAR = 4096;
constexpr int CW_CNT = 16384;

#ifndef FAST_P2
#define FAST_P2 1
#endif
#ifndef FAST_P3
#define FAST_P3 1
#endif
#ifndef FAST_P4
#define FAST_P4 1
#endif
#ifndef FAST_P5
#define FAST_P5 1
#endif
#ifndef FAST_P6
#define FAST_P6 1
#endif
#ifndef FAST_MOE
#define FAST_MOE 1
#endif
constexpr int NWAVES = 8, NTHREADS = 512;
constexpr int LDS_EPI = 131072;
constexpr int LDS_MISC = 147456;
constexpr int LDS_EOFF = 147456 + 256;
constexpr int LDS_BYTES = 147456 + 512;

__device__ __forceinline__ float bf2f(bf16 v) { return __uint_as_float((unsigned)v << 16); }
__device__ __forceinline__ unsigned f2bf(float f) { unsigned u = __float_as_uint(f); return (u + 0x7fffu + ((u >> 16) & 1u)) >> 16; }
__device__ __forceinline__ unsigned pk2(float lo, float hi) { return f2bf(lo) | (f2bf(hi) << 16); }
__device__ __forceinline__ float siluf(float x) { return x / (1.f + __expf(-x)); }
__device__ __forceinline__ float sigm(float x) { return 1.f / (1.f + __expf(-x)); }
__device__ __forceinline__ float wave_sum(float v) {
#pragma unroll
    for (int o = 1; o < 64; o <<= 1) v += __shfl_xor(v, o);
    return v;
}
#define LDS_WAIT() asm volatile("s_waitcnt lgkmcnt(0)" ::: "memory")
__device__ __forceinline__ int lane_id() { int l; asm volatile("v_mbcnt_lo_u32_b32 %0, -1, 0\n\tv_mbcnt_hi_u32_b32 %0, -1, %0" : "=v"(l)); return l; }

#define XB_TMO      128
#define XB_XCNT(j)  (256  + 64 * (j))
#define XB_XSUB(j)  (1280 + 64 * (j))
#define XB_XGEN(j)  (2304 + 64 * (j))
#define XB_TOP      3328
#define XB_TOPGEN   3392
#define XCD_BAR_WORDS 3456
#define XB_SPIN_CAP (1u << 18)
__device__ __forceinline__ unsigned xb_ld(unsigned* p)              { return __hip_atomic_load(p, __ATOMIC_RELAXED, __HIP_MEMORY_SCOPE_AGENT); }
__device__ __forceinline__ unsigned xb_add(unsigned* p, unsigned v) { return __hip_atomic_fetch_add(p, v, __ATOMIC_RELAXED, __HIP_MEMORY_SCOPE_AGENT); }
__device__ __forceinline__ unsigned xb_xcc_id() { return (unsigned)__builtin_amdgcn_s_getreg((3 << 11) | 20) & 0xFu; }
#define XB_SPIN(cond, bar) do { unsigned _sp = 0; while (cond) { __builtin_amdgcn_s_sleep(1); \
    if ((++_sp & 255u) == 0u) { if (xb_ld(&(bar)[XB_TMO])) break; if (_sp > XB_SPIN_CAP) { atomicAdd(&(bar)[XB_TMO], 1u); break; } } } } while (0)
struct XcdBarrier { unsigned* bar; unsigned x; volatile LAS unsigned* st; };
__device__ __forceinline__ XcdBarrier xcd_barrier_post(unsigned* bar, volatile LAS unsigned* st) {
    XcdBarrier b; b.bar = bar; b.x = xb_xcc_id(); b.st = st;
    if (threadIdx.x == 0) (void)xb_add(&bar[XB_XCNT(b.x)], 1u);
    return b;
}
__device__ __forceinline__ void xcd_barrier_complete(unsigned* bar, unsigned x, unsigned& nloc, unsigned& nx) {
    const unsigned G = gridDim.x * gridDim.y * gridDim.z;
    unsigned sum, cnt, mine, sp = 0u;
    for (;;) {
        sum = 0u; cnt = 0u; mine = 0u;
#pragma unroll
        for (unsigned j = 0; j < 16; ++j) { const unsigned c = xb_ld(&bar[XB_XCNT(j)]); sum += c; cnt += (c > 0u) ? 1u : 0u; mine = (j == x) ? c : mine; }
        if (sum == G) break;
        __builtin_amdgcn_s_sleep(1);
        if ((++sp & 255u) == 0u) { if (xb_ld(&bar[XB_TMO])) break; if (sp > XB_SPIN_CAP) { atomicAdd(&bar[XB_TMO], 1u); break; } }
    }
    nloc = mine > 0u ? mine : 1u; nx = cnt > 0u ? cnt : 1u;
}
__device__ __forceinline__ void xcd_barrier(const XcdBarrier& b) {
    asm volatile("s_waitcnt vmcnt(0)" ::: "memory");
    __syncthreads();
    if (threadIdx.x == 0) {
        unsigned* bar = b.bar;
        __builtin_amdgcn_s_waitcnt(0);
        unsigned nloc = b.st[0], nx = b.st[1];
        if (nloc == 0u) { xcd_barrier_complete(bar, b.x, nloc, nx); b.st[0] = nloc; b.st[1] = nx; }
        const unsigned old = xb_add(&bar[XB_XSUB(b.x)], 1u);
        const unsigned gen = old / nloc;
        if (old + 1u == (gen + 1u) * nloc) {
            __builtin_amdgcn_fence(__ATOMIC_RELEASE, "agent");
            asm volatile("s_waitcnt vmcnt(0)" ::: "memory");
            const unsigned og = xb_add(&bar[XB_TOP], 1u);
            const unsigned tg = og / nx;
            if (og + 1u == (tg + 1u) * nx) xb_add(&bar[XB_TOPGEN], 1u);
            else XB_SPIN(xb_ld(&bar[XB_TOPGEN]) == tg, bar);
            __builtin_amdgcn_fence(__ATOMIC_ACQUIRE, "agent");
            xb_add(&bar[XB_XGEN(b.x)], 1u);
            asm volatile("s_waitcnt vmcnt(0)" ::: "memory");
        } else {
            XB_SPIN(xb_ld(&bar[XB_XGEN(b.x)]) == gen, bar);
            __builtin_amdgcn_fence(__ATOMIC_ACQUIRE, "agent");
            asm volatile("s_waitcnt vmcnt(0)" ::: "memory");
        }
    }
    __syncthreads();
}

struct Params { const float* in[22]; float* out; unsigned char* ws; };
enum { I_X = 0, I_C, I_CTX, I_CCTX, I_WMOD, I_BMOD, I_N1W, I_N2W, I_WIN, I_DECAY, I_GNW, I_WRETO, I_CONVW, I_WCONVO, I_WOUT, I_RGW, I_RGB, I_REW, I_REB, I_W13, I_W2, I_FNW };

struct Ctx {
    int tid, lane, wave, gw, ngw;
    LAS unsigned char* lds;
};

struct NSeg { const bf16* A; const bf16* B; int lda, ldb, K; };
template <int NS>
__device__ __forceinline__ void ngemm_acc(f32x4 (&acc)[4][4], const NSeg (&sg)[NS], int m0, int n0, int lane) {
    const int fr = lane & 15, fq = lane >> 4;
#pragma unroll
    for (int s = 0; s < NS; ++s) {
        const bf16* Ap = sg[s].A + (size_t)(m0 + fr) * sg[s].lda + 8 * fq;
        const bf16* Bp = sg[s].B + (size_t)(n0 + fr) * sg[s].ldb + 8 * fq;
        const size_t as = (size_t)16 * sg[s].lda, bs = (size_t)16 * sg[s].ldb;
        for (int k0 = 0; k0 < sg[s].K; k0 += 32) {
            bf16x8 a[4], b[4];
#pragma unroll
            for (int i = 0; i < 4; ++i) { a[i] = *(const bf16x8*)(Ap + i * as + k0); b[i] = *(const bf16x8*)(Bp + i * bs + k0); }
#pragma unroll
            for (int i = 0; i < 4; ++i)
#pragma unroll
                for (int j = 0; j < 4; ++j) acc[i][j] = __builtin_amdgcn_mfma_f32_16x16x32_bf16(b[j], a[i], acc[i][j], 0, 0, 0);
        }
    }
}
__device__ __forceinline__ void acc_zero(f32x4 (&acc)[4][4]) {
#pragma unroll
    for (int i = 0; i < 4; ++i)
#pragma unroll
        for (int j = 0; j < 4; ++j) acc[i][j] = (f32x4){0.f, 0.f, 0.f, 0.f};
}
template <class Epi>
__device__ __forceinline__ void ngemm(const Ctx& C, const bf16* A, int lda, const bf16* B, int ldb, int M, int N, int K, Epi epi) {
    const int tn = N / 64, nt = (M / 64) * tn;
    const int fr = C.lane & 15, fq = C.lane >> 4;
    for (int t = C.gw; t < nt; t += C.ngw) {
        const int m0 = (t / tn) * 64, n0 = (t % tn) * 64;
        f32x4 acc[4][4]; acc_zero(acc);
        const NSeg sg[1] = {{A, B, lda, ldb, K}};
        ngemm_acc<1>(acc, sg, m0, n0, C.lane);
#pragma unroll
        for (int i = 0; i < 4; ++i)
#pragma unroll
            for (int j = 0; j < 4; ++j) epi(m0 + 16 * i + fr, n0 + 16 * j + 4 * fq, acc[i][j]);
    }
}
__device__ __forceinline__ void st_bf4(bf16* p, f32x4 v) { v2u w; w.x = pk2(v[0], v[1]); w.y = pk2(v[2], v[3]); *(v2u*)p = w; }
__device__ __forceinline__ f32x4 ld_bf4(const bf16* p) { const v2u w = *(const v2u*)p; return (f32x4){__uint_as_float(w.x << 16), __uint_as_float(w.x & 0xffff0000u), __uint_as_float(w.y << 16), __uint_as_float(w.y & 0xffff0000u)}; }

__device__ __forceinline__ void transpose_item(const float* W, int ldw, int k0, int srccol, bf16* dst0, int dpitch, LAS float* scr, int lane) {
    float tv[32];
#pragma unroll
    for (int i = 0; i < 32; ++i) tv[i] = W[(size_t)(k0 + 2 * i + (lane >> 5)) * ldw + srccol];
#pragma unroll
    for (int i = 0; i < 32; ++i) scr[(2 * i + (lane >> 5)) * 33 + (lane & 31)] = tv[i];
    LDS_WAIT(); asm volatile("" ::: "memory");
    const int c = lane & 7;
#pragma unroll
    for (int j = 0; j < 4; ++j) { const int n = (lane >> 3) + 8 * j; const LAS float* s = scr + (8 * c) * 33 + n;
        v4u o; o.x = pk2(s[0 * 33], s[1 * 33]); o.y = pk2(s[2 * 33], s[3 * 33]); o.z = pk2(s[4 * 33], s[5 * 33]); o.w = pk2(s[6 * 33], s[7 * 33]);
        *(v4u*)(dst0 + (size_t)n * dpitch + 8 * c) = o; }
    LDS_WAIT(); asm volatile("" ::: "memory");
}
__device__ __forceinline__ int win_src(int rho) {
    if (rho < R_V) {
        const int base = rho < R_K ? OFF_Q : OFF_K, r = rho & 1023, h = r >> 8, p = r & 255;
        const int half = p >> 7, pp = p & 127, i = pp >> 1, s = pp & 1;
        return base + h * 256 + half * 128 + s * 64 + i;
    }
    if (rho < R_CCH) return rho;
    if (rho < R_GATE) { const int r = rho - R_CCH, g = r >> 8, w = r & 255; return w < 128 ? OFF_CC + g * 128 + w : OFF_CH + g * 128 + (w - 128); }
    return rho;
}


namespace pg8 {
constexpr int BM = 256, BK = 64, HALF = 128, HTB = HALF * BK * 2, STAGE_BYTES = 8 * HTB;
__device__ __forceinline__ int lds_byte(int r, int c) { const int st = (r >> 4) * 2 + (c >> 5), rr = r & 15, cc = c & 31, ob = rr * 64 + cc * 2; return st * 1024 + (ob ^ (((ob >> 9) & 1) << 5)); }
__device__ __forceinline__ void stage_rc(int b, int& R, int& C) { const int st = b / 1024, sb = b % 1024, swz = sb ^ (((sb >> 9) & 1) << 5); R = (st >> 1) * 16 + swz / 64; C = (st & 1) * 32 + (swz % 64) / 2; }
__device__ __forceinline__ int perm32(int rho) { const int n = rho >> 4, i = rho & 15; return 8 * (i >> 2) + 4 * n + (i & 3); }
struct Seg { const char* A; const char* B; int lda, ldb; int nt; int act; int u0, u1, u2, u3; };
typedef f32x4 Acc[2][2][4][2];
__device__ __forceinline__ void acc_zero(Acc& acc) {
#pragma unroll
    for (int a = 0; a < 2; ++a)
#pragma unroll
        for (int b = 0; b < 2; ++b)
#pragma unroll
            for (int m = 0; m < 4; ++m)
#pragma unroll
                for (int n = 0; n < 2; ++n) acc[a][b][m][n] = (f32x4){0.f, 0.f, 0.f, 0.f};
}
template <class Sched, class Epi>
__device__ __forceinline__ void gemm_stream(LAS unsigned char* lds, int wid, const Sched& S, const Epi& E) {
    const int lane = lane_id(), tid = wid * 64 + lane;
    const int wr = wid >> 2, wc = wid & 3, fr = lane & 15, fq = lane >> 4;
    int R0, C0; stage_rc(tid * 16, R0, C0); const int Rb0 = (R0 & ~31) + perm32(R0 & 31);
    const unsigned ldsw = (unsigned)wid * 1024u;
    const int aoff = lds_byte(wr * 64 + fr, fq * 8), boff = lds_byte(wc * 32 + fr, fq * 8);
    const size_t kstep = (size_t)(BK * 2);
#define PG8_SA(b, h) (((b) * 2 + (h)) * HTB)
#define PG8_SB(b, h) ((4 + (b) * 2 + (h)) * HTB)
#define PG8_STAGE(bufoff, gbase, voff, rs) do { _Pragma("unroll") for (int _i = 0; _i < 2; ++_i) { const char* _p = (const char*)(gbase) + (size_t)_i * 64 * (rs); asm volatile("" : "+s"(_p));   \
        __builtin_amdgcn_global_load_lds((const unsigned*)(_p + (voff)), (LAS unsigned*)(lds + (bufoff) + ldsw + _i * 8192), 16, 0, 0); } } while (0)
#define PG8_LDA(dst, b, h) do { _Pragma("unroll") for (int m = 0; m < 4; ++m) _Pragma("unroll") for (int k = 0; k < 2; ++k) dst[m][k] = *(const LAS bf16x8*)(lds + PG8_SA(b, h) + aoff + m * 2048 + k * 1024); } while (0)
#define PG8_LDB(dst, b, h) do { _Pragma("unroll") for (int n = 0; n < 2; ++n) _Pragma("unroll") for (int k = 0; k < 2; ++k) dst[n][k] = *(const LAS bf16x8*)(lds + PG8_SB(b, h) + boff + n * 2048 + k * 1024); } while (0)
#define PG8_MMA(ai, bj, At, Bt) do { __builtin_amdgcn_s_setprio(1); _Pragma("unroll") for (int m = 0; m < 4; ++m) _Pragma("unroll") for (int n = 0; n < 2; ++n) _Pragma("unroll") for (int k = 0; k < 2; ++k) \
        acc[ai][bj][m][n] = __builtin_amdgcn_mfma_f32_16x16x32_bf16(Bt[n][k], At[m][k], acc[ai][bj][m][n], 0, 0, 0); __builtin_amdgcn_s_setprio(0); } while (0)
#define PG8_WAIT_V(n) asm volatile("s_waitcnt vmcnt(" #n ")" ::: "memory")
#define PG8_WAIT_L(n) asm volatile("s_waitcnt lgkmcnt(" #n ")" ::: "memory")
#define PG8_BAR __builtin_amdgcn_s_barrier()
#define PG8_SCHED __builtin_amdgcn_sched_barrier(0)
    Seg cur, nxt; int si = 0;
    if (!S.next(0, cur)) return;
    Acc acc; acc_zero(acc);
    bf16x8 At[4][2], B0[2][2], B1[2][2];
    int rsA = cur.lda, rsB = cur.ldb;
    unsigned vA = (unsigned)(R0 * rsA + C0 * 2), vB = (unsigned)(Rb0 * rsB + C0 * 2);
    size_t hsA = (size_t)HALF * rsA, hsB = (size_t)HALF * rsB;
    const char* cA = cur.A; const char* cB = cur.B;
    PG8_STAGE(PG8_SB(0, 0), cB, vB, rsB); PG8_STAGE(PG8_SB(0, 1), cB + hsB, vB, rsB); PG8_STAGE(PG8_SA(0, 0), cA, vA, rsA); PG8_STAGE(PG8_SA(0, 1), cA + hsA, vA, rsA);
    if (wr == 1) PG8_BAR;
    PG8_WAIT_V(2); PG8_BAR;
    PG8_STAGE(PG8_SB(1, 0), cB + kstep, vB, rsB); PG8_STAGE(PG8_SA(1, 0), cA + kstep, vA, rsA); PG8_STAGE(PG8_SB(1, 1), cB + hsB + kstep, vB, rsB);
    PG8_WAIT_V(6); PG8_BAR;
    for (;;) {
        const bool has_next = S.next(si + 1, nxt);
        const char* nA = has_next ? nxt.A : cA; const char* nB = has_next ? nxt.B : cB;
        const int nrsA = has_next ? nxt.lda : cur.lda, nrsB = has_next ? nxt.ldb : cur.ldb;
        const int nt = cur.nt;
        for (int t = 0; t < nt; t += 2) {
            const bool last = (t == nt - 2);
            const char* a1 = cA + (size_t)(t + 1) * kstep;
            PG8_LDB(B0, 0, 0); PG8_LDB(B1, 0, 1); PG8_SCHED; PG8_LDA(At, 0, 0); PG8_STAGE(PG8_SA(1, 1), a1 + hsA, vA, rsA);
            if (last) {
                int R1, C1; stage_rc((wid * 64 + lane_id()) * 16, R1, C1); const int Rb1 = (R1 & ~31) + perm32(R1 & 31);
                rsA = nrsA; rsB = nrsB; vA = (unsigned)(R1 * rsA + C1 * 2); vB = (unsigned)(Rb1 * rsB + C1 * 2); hsA = (size_t)HALF * rsA; hsB = (size_t)HALF * rsB; }
            const char* a2 = last ? nA : cA + (size_t)(t + 2) * kstep; const char* b2 = last ? nB : cB + (size_t)(t + 2) * kstep;
            const char* a3 = a2 + kstep; const char* b3 = b2 + kstep;
            PG8_WAIT_V(8); PG8_WAIT_L(0); PG8_BAR; PG8_MMA(0, 0, At, B0); PG8_MMA(0, 1, At, B1); PG8_BAR; PG8_SCHED;
            PG8_LDA(At, 0, 1); PG8_STAGE(PG8_SB(0, 0), b2, vB, rsB); PG8_STAGE(PG8_SB(0, 1), b2 + hsB, vB, rsB); PG8_STAGE(PG8_SA(0, 0), a2, vA, rsA);
            PG8_WAIT_V(8); PG8_WAIT_L(0); PG8_BAR; PG8_MMA(1, 0, At, B0); PG8_MMA(1, 1, At, B1); PG8_BAR; PG8_SCHED;
            PG8_LDB(B0, 1, 0); PG8_LDB(B1, 1, 1); PG8_SCHED; PG8_LDA(At, 1, 0); PG8_STAGE(PG8_SA(0, 1), a2 + hsA, vA, rsA);
            PG8_WAIT_V(8); PG8_WAIT_L(0); PG8_BAR; PG8_MMA(0, 0, At, B0); PG8_MMA(0, 1, At, B1); PG8_BAR; PG8_SCHED;
            PG8_LDA(At, 1, 1); PG8_STAGE(PG8_SB(1, 0), b3, vB, rsB); PG8_STAGE(PG8_SB(1, 1), b3 + hsB, vB, rsB); PG8_STAGE(PG8_SA(1, 0), a3, vA, rsA);
            PG8_WAIT_V(8); PG8_WAIT_L(0); PG8_BAR; PG8_MMA(1, 0, At, B0); PG8_MMA(1, 1, At, B1); PG8_BAR; PG8_SCHED;
        }
        if (cur.act != 0) {
            if (wr == 0) PG8_BAR;
            E.after(acc, cur, wid);
            if (!has_next) break;
            if (wr == 1) PG8_BAR;
        }
        cur = nxt; cA = nA; cB = nB; ++si;
    }
    PG8_WAIT_V(0);
    PG8_BAR;
#undef PG8_SA
#undef PG8_SB
#undef PG8_STAGE
#undef PG8_LDA
#undef PG8_LDB
#undef PG8_MMA
#undef PG8_WAIT_V
#undef PG8_WAIT_L
#undef PG8_BAR
#undef PG8_SCHED
}
}
__device__ __forceinline__ v4u pk8(f32x4 a, f32x4 b) { v4u w; w.x = pk2(a[0], a[1]); w.y = pk2(a[2], a[3]); w.z = pk2(b[0], b[1]); w.w = pk2(b[2], b[3]); return w; }
__device__ __forceinline__ void ld_bf8(const bf16* p, f32x4& a, f32x4& b) { const v4u w = *(const v4u*)p;
    a = (f32x4){__uint_as_float(w.x << 16), __uint_as_float(w.x & 0xffff0000u), __uint_as_float(w.y << 16), __uint_as_float(w.y & 0xffff0000u)};
    b = (f32x4){__uint_as_float(w.z << 16), __uint_as_float(w.z & 0xffff0000u), __uint_as_float(w.w << 16), __uint_as_float(w.w & 0xffff0000u)}; }


#define DPP_ROR1(x)  __int_as_float(__builtin_amdgcn_update_dpp(0, __float_as_int(x), 0x121, 0xF, 0xF, false))
#define DPP_ROL1(x)  __int_as_float(__builtin_amdgcn_update_dpp(0, __float_as_int(x), 0x12F, 0xF, 0xF, false))
#define DPP_XOR1(x)  __int_as_float(__builtin_amdgcn_update_dpp(0, __float_as_int(x), 0xB1, 0xF, 0xF, false))
struct P2Sched {
    int vcu; const char* HX; const char* WIN;
    __device__ __forceinline__ bool next(int i, pg8::Seg& s) const {
        const int x = vcu >> 5, j = vcu & 31, q = j >> 3; int tok = 8 * x + (j & 7);
        int act, wrow, u0, u1; bool sw = false;
        if (i == 0) { act = 1; wrow = R_CB + 256 * q; u1 = q; }
        else if (i <= 2) { act = 2; u1 = 2 * q + (i - 1); wrow = R_CCH + 256 * u1; }
        else if (i == 3) { act = 3; wrow = R_Q + 256 * q; u1 = q; }
        else if (i == 4) { act = 4; wrow = R_K + 256 * q; u1 = q; }
        else if (i <= 6) { act = 5; u1 = 2 * q + (i - 5); wrow = R_G + 256 * u1; }
        else if (i <= 8) { act = 6; u1 = 2 * q + (i - 7); wrow = R_GATE + 256 * u1; }
        else if (i == 9) { act = 7; sw = true; u0 = q; wrow = R_K + 256 * q; }
        else if (i <= 11) { act = 8; sw = true; u0 = 2 * q + (i - 10); wrow = R_V + 256 * u0; }
        else if (i == 12 && vcu < 48) { const int a = vcu % 12; tok = 64 + vcu / 12; sw = true; if (a < 4) { act = 7; u0 = a; wrow = R_K + 256 * a; } else { act = 8; u0 = a - 4; wrow = R_V + 256 * (a - 4); } }
        else return false;
        const char* hp = HX + (size_t)tok * 256 * 2048; const char* wp = WIN + (size_t)wrow * 2048;
        if (sw) { s.A = wp; s.B = hp; s.u0 = u0; s.u1 = tok; } else { s.A = hp; s.B = wp; s.u0 = tok; s.u1 = u1; }
        s.lda = 2048; s.ldb = 2048; s.nt = 16; s.act = act; s.u2 = 0; s.u3 = 0;
        return true;
    }
};
struct P2Epi {
    bf16 *ACAT, *KB, *KTF, *KTB, *VT, *SG, *CBU, *G1, *G2; const float *RC, *RS, *RCT, *RST, *DEC, *convw;
    __device__ __forceinline__ void after(pg8::Acc& acc, const pg8::Seg& s, int wid) const {
        const int lane = lane_id(), wr = wid >> 2, wc = wid & 3, fr = lane & 15, fq = lane >> 4;
        int su0 = s.u0, su1 = s.u1; asm volatile("" : "+s"(su0), "+s"(su1));
        int rbase = 64 * wr + fr, cbase = 32 * wc + 8 * fq; const int act = s.act;
        asm volatile("" : "+v"(rbase), "+v"(cbase));
        if (act == 3 || act == 4) {
            const int h = su1;
            const float lf = DEC[h], lb = DEC[4 + h];
#pragma unroll
            for (int ai = 0; ai < 2; ++ai)
#pragma unroll
                for (int m = 0; m < 4; ++m) {
                    const int t = 256 * su0 + 128 * ai + rbase + 16 * m, n = t & (SEQ - 1), i = n & (CH - 1);
                    const float xf = exp2f(lf * (float)(i + 1)), xb = exp2f(lb * (float)(CH - i));
#pragma unroll
                    for (int bj = 0; bj < 2; ++bj) {
                        const int pos = bj ? (n & 63) : (n >> 6), p0 = 128 * bj + cbase;
                        const f32x4 cs = *(const f32x4*)(RC + pos * 64 + (cbase >> 1)), sn = *(const f32x4*)(RS + pos * 64 + (cbase >> 1));
                        const f32x4 v0 = acc[ai][bj][m][0], v1 = acc[ai][bj][m][1];
                        const f32x4 o0 = (f32x4){v0[0] * cs[0] - v0[1] * sn[0], v0[0] * sn[0] + v0[1] * cs[0], v0[2] * cs[1] - v0[3] * sn[1], v0[2] * sn[1] + v0[3] * cs[1]};
                        const f32x4 o1 = (f32x4){v1[0] * cs[2] - v1[1] * sn[2], v1[0] * sn[2] + v1[1] * cs[2], v1[2] * cs[3] - v1[3] * sn[3], v1[2] * sn[3] + v1[3] * cs[3]};
                        if (act == 3) { bf16* dst = ACAT + ((size_t)h * T + t) * 768 + p0; *(v4u*)(dst + 256) = pk8(o0 * xf, o1 * xf); *(v4u*)(dst + 512) = pk8(o0 * xb, o1 * xb); }
                        else *(v4u*)(KB + (size_t)t * QKW + h * DK + p0) = pk8(o0 * 0.0625f, o1 * 0.0625f);
                    }
                }
        } else if (act == 5 || act == 6 || act == 1) {
            bf16* base; int ld;
            if (act == 5) { base = SG + 256 * su1; ld = VW; } else if (act == 6) { base = (su1 < 4 ? G1 + 256 * su1 : G2 + 256 * (su1 - 4)); ld = DM; } else { base = CBU + 256 * su1; ld = DM; }
#pragma unroll
            for (int ai = 0; ai < 2; ++ai)
#pragma unroll
                for (int m = 0; m < 4; ++m) {
                    const int t = 256 * su0 + 128 * ai + rbase + 16 * m;
#pragma unroll
                    for (int bj = 0; bj < 2; ++bj) {
                        f32x4 v0 = acc[ai][bj][m][0], v1 = acc[ai][bj][m][1];
                        if (act == 5) {
#pragma unroll
                            for (int e = 0; e < 4; ++e) { v0[e] = siluf(v0[e]); v1[e] = siluf(v1[e]); }
                        } else if (act == 6) {
#pragma unroll
                            for (int e = 0; e < 4; ++e) { v0[e] = sigm(v0[e]); v1[e] = sigm(v1[e]); }
                        }
                        *(v4u*)(base + (size_t)t * ld + 128 * bj + cbase) = pk8(v0, v1);
                    }
                }
            if (act == 1) asm volatile("s_waitcnt vmcnt(0)" ::: "memory");
        } else if (act == 2) {
            const int c0 = 128 * su1 + cbase;
            f32x4 w0[2], w1[2], w2[2];
#pragma unroll
            for (int n = 0; n < 2; ++n) { w0[n] = *(const f32x4*)(convw + c0 + 4 * n); w1[n] = *(const f32x4*)(convw + DM + c0 + 4 * n); w2[n] = *(const f32x4*)(convw + 2 * DM + c0 + 4 * n); }
#pragma unroll
            for (int ai = 0; ai < 2; ++ai) {
#pragma unroll
                for (int m = 0; m < 4; ++m)
#pragma unroll
                    for (int n = 0; n < 2; ++n) acc[ai][0][m][n] = acc[ai][0][m][n] * acc[ai][1][m][n];
#pragma unroll
                for (int m = 0; m < 4; ++m)
#pragma unroll
                    for (int n = 0; n < 2; ++n) {
                        const f32x4 cu = acc[ai][0][m][n]; f32x4 pv, nx;
#pragma unroll
                        for (int e = 0; e < 4; ++e) {
                            float a = DPP_ROR1(cu[e]), b = DPP_ROL1(cu[e]);
                            float ab = 0.f, bb = 0.f;
                            if (m > 0) ab = DPP_ROR1(acc[ai][0][m > 0 ? m - 1 : 0][n][e]);
                            if (m < 3) bb = DPP_ROL1(acc[ai][0][m < 3 ? m + 1 : 3][n][e]);
                            pv[e] = fr == 0 ? ab : a; nx[e] = fr == 15 ? bb : b;
                        }
                        acc[ai][1][m][n] = w0[n] * pv + w1[n] * cu + w2[n] * nx;
                    }
#pragma unroll
                for (int m = 0; m < 4; ++m) {
                    const int t = 256 * su0 + 128 * ai + rbase + 16 * m;
                    bf16* ptr = CBU + (size_t)t * DM + c0; f32x4 cb0, cb1; ld_bf8(ptr, cb0, cb1);
                    *(v4u*)ptr = pk8(cb0 * acc[ai][1][m][0], cb1 * acc[ai][1][m][1]);
                }
            }
        } else if (act == 7) {
            const int h = su0; const bool latent = su1 < 64;
            const float lf = DEC[h], lb = DEC[4 + h], gif = exp2f(-lf), gb = exp2f(lb);
#pragma unroll
            for (int bj = 0; bj < 2; ++bj) {
                const int tc0 = 256 * su1 + 128 * bj + cbase, n0 = tc0 & (SEQ - 1), j0 = tc0 & (CH - 1);
                float wf[8], wb[8];
                wf[0] = exp2f(lf * (float)(CH - 1 - j0)) * 0.0625f; wb[0] = exp2f(lb * (float)j0) * 0.0625f;
#pragma unroll
                for (int e = 1; e < 8; ++e) { wf[e] = wf[e - 1] * gif; wb[e] = wb[e - 1] * gb; }
#pragma unroll
                for (int ai = 0; ai < 2; ++ai)
#pragma unroll
                    for (int m = 0; m < 4; ++m) {
                        const int p = 128 * ai + rbase + 16 * m, fi = (p & 127) >> 1;
                        const f32x4 v0 = acc[ai][bj][m][0], v1 = acc[ai][bj][m][1];
                        f32x4 o0 = v0, o1 = v1;
                        if (latent) {
                            f32x4 p0, p1;
#pragma unroll
                            for (int e = 0; e < 4; ++e) { p0[e] = DPP_XOR1(v0[e]); p1[e] = DPP_XOR1(v1[e]); }
                            f32x4 c0, c1, s0, s1;
                            if (ai == 0) { const float cv = RC[(n0 >> 6) * 64 + fi], sv = RS[(n0 >> 6) * 64 + fi]; c0 = (f32x4){cv, cv, cv, cv}; c1 = c0; s0 = (f32x4){sv, sv, sv, sv}; s1 = s0; }
                            else { const float* cp = RCT + fi * 64 + (n0 & 63); const float* sp = RST + fi * 64 + (n0 & 63); c0 = *(const f32x4*)cp; c1 = *(const f32x4*)(cp + 4); s0 = *(const f32x4*)sp; s1 = *(const f32x4*)(sp + 4); }
                            if (fr & 1) { o0 = p0 * s0 + v0 * c0; o1 = p1 * s1 + v1 * c1; } else { o0 = v0 * c0 - p0 * s0; o1 = v1 * c1 - p1 * s1; }
                        }
                        f32x4 f0, f1, b0, b1;
#pragma unroll
                        for (int e = 0; e < 4; ++e) { f0[e] = o0[e] * wf[e]; f1[e] = o1[e] * wf[4 + e]; b0[e] = o0[e] * wb[e]; b1[e] = o1[e] * wb[4 + e]; }
                        const size_t off = (size_t)(h * DK + p) * TP + tc0;
                        *(v4u*)(KTF + off) = pk8(f0, f1); *(v4u*)(KTB + off) = pk8(b0, b1);
                    }
            }
        } else {
#pragma unroll
            for (int ai = 0; ai < 2; ++ai)
#pragma unroll
                for (int m = 0; m < 4; ++m)
#pragma unroll
                    for (int bj = 0; bj < 2; ++bj)
                        *(v4u*)(VT + (size_t)(256 * su0 + 128 * ai + rbase + 16 * m) * TP + 256 * su1 + 128 * bj + cbase) = pk8(acc[ai][bj][m][0], acc[ai][bj][m][1]);
        }
        pg8::acc_zero(acc);
    }
};


template <int MODE> struct P3Sched {
    int vcu; const char *VT, *KTF, *KTB, *ACAT, *KB;
    __device__ __forceinline__ bool next(int i, pg8::Seg& s) const {
        if (MODE == 0) {
            if (i >= NCH) return false;
            const int half = vcu & 1, dir = (vcu >> 1) & 1, h = (vcu >> 2) & 3, b = vcu >> 4;
            const int tc0 = i == 0 ? T + b * CTXL : b * SEQ + (dir ? (NCH - i) : (i - 1)) * CH;
            s.A = VT + ((size_t)(h * DV + half * 256) * TP + tc0) * 2; s.B = KTF + ((size_t)(dir * QKW + h * DK) * TP + tc0) * 2;
            s.lda = TP * 2; s.ldb = TP * 2; s.nt = 4; s.act = 1;
            s.u0 = b * SEQ + (dir ? (NCH - 1 - i) : i) * CH; s.u1 = h * DV + half * 256; s.u2 = dir * 4 + h; s.u3 = dir;
            return true;
        }
        const int u = vcu - 64 + 192 * i; if (i >= 2 || u >= NB * NCH * NH) return false;
        const int h = u & 3, t0 = (u >> 2) * CH;
        s.A = ACAT + (((size_t)h * T + t0) * 768 + 256) * 2; s.B = KB + ((size_t)t0 * QKW + h * DK) * 2;
        s.lda = 768 * 2; s.ldb = QKW * 2; s.nt = 4; s.act = 2; s.u0 = h; s.u1 = t0; s.u2 = 0; s.u3 = 0;
        return true;
    }
};
template <int MODE> struct P3Epi {
    bf16 *STF, *STB, *ACAT; const float* DEC;
    __device__ __forceinline__ void after(pg8::Acc& acc, const pg8::Seg& s, int wid) const {
        const int lane = lane_id(), wr = wid >> 2, wc = wid & 3, fr = lane & 15, fq = lane >> 4;
        int su0 = s.u0, su1 = s.u1, su2 = s.u2; asm volatile("" : "+s"(su0), "+s"(su1), "+s"(su2));
        int rbase = 64 * wr + fr, cbase = 32 * wc + 8 * fq; asm volatile("" : "+v"(rbase), "+v"(cbase));
        if (MODE == 0) {
            bf16* ST = s.u3 ? STB : STF; const float dec = exp2f(DEC[su2] * (float)CH);
#pragma unroll
            for (int ai = 0; ai < 2; ++ai)
#pragma unroll
                for (int m = 0; m < 4; ++m)
#pragma unroll
                    for (int bj = 0; bj < 2; ++bj) {
                        *(v4u*)(ST + (size_t)(su1 + 128 * ai + rbase + 16 * m) * TP + su0 + 128 * bj + cbase) = pk8(acc[ai][bj][m][0], acc[ai][bj][m][1]);
                        acc[ai][bj][m][0] = acc[ai][bj][m][0] * dec; acc[ai][bj][m][1] = acc[ai][bj][m][1] * dec;
                    }
        } else {
            const float lf = DEC[su0], lb = DEC[4 + su0];
            bf16* Ah = ACAT + ((size_t)su0 * T + su1) * 768;
#pragma unroll
            for (int bj = 0; bj < 2; ++bj) {
                int j0 = 128 * bj + cbase; asm volatile("" : "+v"(j0));
                float cf[8], cb[8];
#pragma unroll
                for (int e = 0; e < 8; ++e) { cf[e] = exp2f(-lf * (float)(j0 + e + 1)); cb[e] = exp2f(lb * (float)(j0 + e)); }
#pragma unroll
                for (int ai = 0; ai < 2; ++ai)
#pragma unroll
                    for (int m = 0; m < 4; ++m) {
                        const int ii = 128 * ai + rbase + 16 * m; const float rb = exp2f(-lb * (float)ii - lf * (float)(ii + 1));
#pragma unroll
                        for (int n = 0; n < 2; ++n)
#pragma unroll
                            for (int e = 0; e < 4; ++e) acc[ai][bj][m][n][e] *= (j0 + 4 * n + e <= ii) ? cf[4 * n + e] : cb[4 * n + e] * rb;
                        *(v4u*)(Ah + (size_t)ii * 768 + j0) = pk8(acc[ai][bj][m][0], acc[ai][bj][m][1]);
                    }
            }
            pg8::acc_zero(acc);
        }
    }
};
struct P4Sched {
    int vcu; const char* ws;
    __device__ __forceinline__ bool next(int i, pg8::Seg& s) const {
        if (i >= 6) return false;
        const int h = vcu & 3, t0 = (vcu >> 2) * CH, half = i / 3, sg = i % 3;
        s.A = ws + WS_ACAT + (((size_t)h * T + t0) * 768 + 256 * sg) * 2;
        const size_t boff = sg == 0 ? WS_VT : WS_ST + (size_t)(sg - 1) * VW * TP * 2;
        s.B = ws + boff + ((size_t)(h * DV + half * 256) * TP + t0) * 2;
        s.lda = 768 * 2; s.ldb = TP * 2; s.nt = 4; s.act = sg == 2 ? 1 + half : 0; s.u0 = t0; s.u1 = h; s.u2 = 0; s.u3 = 0;
        return true;
    }
};
struct P4Epi {
    bf16* YG; const bf16* SG; const float* gnw; LAS unsigned char* lds;
    __device__ __forceinline__ void after(pg8::Acc& acc, const pg8::Seg& s, int wid) const {
        const int lane = lane_id(), wr = wid >> 2, wc = wid & 3, fr = lane & 15, fq = lane >> 4;
        typedef float f32x2v __attribute__((ext_vector_type(2)));
        int su0 = s.u0, su1 = s.u1; asm volatile("" : "+s"(su0), "+s"(su1));
        int rbase = 64 * wr + fr, cbase = 32 * wc + 8 * fq; asm volatile("" : "+v"(rbase), "+v"(cbase));
        const int half = s.act - 1;
        LAS f32x2v* PS = (LAS f32x2v*)(lds + LDS_EPI) + half * 1024;
        LAS f32x2v* SR = (LAS f32x2v*)(lds + LDS_EPI);
#pragma unroll
        for (int ai = 0; ai < 2; ++ai)
#pragma unroll
            for (int m = 0; m < 4; ++m) {
                float sm = 0.f, sq = 0.f;
#pragma unroll
                for (int bj = 0; bj < 2; ++bj)
#pragma unroll
                    for (int n = 0; n < 2; ++n) { const f32x4 x = acc[ai][bj][m][n]; sm += (x[0] + x[1]) + (x[2] + x[3]); sq += (x[0] * x[0] + x[1] * x[1]) + (x[2] * x[2] + x[3] * x[3]); }
                sm += __shfl_xor(sm, 16); sm += __shfl_xor(sm, 32); sq += __shfl_xor(sq, 16); sq += __shfl_xor(sq, 32);
                if (fq == 0) PS[(128 * ai + rbase + 16 * m) * 4 + wc] = (f32x2v){sm, sq};
            }
        bf16* yrow = YG + (size_t)su0 * VW + su1 * DV;
        if (half == 0) {
#pragma unroll
            for (int ai = 0; ai < 2; ++ai)
#pragma unroll
                for (int m = 0; m < 4; ++m)
#pragma unroll
                    for (int bj = 0; bj < 2; ++bj) *(v4u*)(yrow + (size_t)(128 * ai + rbase + 16 * m) * VW + 128 * bj + cbase) = pk8(acc[ai][bj][m][0], acc[ai][bj][m][1]);
        } else {
            asm volatile("s_waitcnt vmcnt(0) lgkmcnt(0)" ::: "memory"); __builtin_amdgcn_s_barrier(); asm volatile("" ::: "memory");
            const int tid = wid * 64 + lane;
            float mean = 0.f, rstd = 0.f;
            if (tid < 256) { float sm = 0.f, sq = 0.f;
#pragma unroll
                for (int k = 0; k < 8; ++k) { const f32x2v p = ((LAS f32x2v*)(lds + LDS_EPI))[(k >> 2) * 1024 + tid * 4 + (k & 3)]; sm += p.x; sq += p.y; }
                mean = sm * (1.f / DV); rstd = rsqrtf(fmaxf(sq * (1.f / DV) - mean * mean, 0.f) + 1e-5f); }
            asm volatile("s_waitcnt lgkmcnt(0)" ::: "memory"); __builtin_amdgcn_s_barrier(); asm volatile("" ::: "memory");
            if (tid < 256) SR[tid] = (f32x2v){mean, rstd};
            asm volatile("s_waitcnt lgkmcnt(0)" ::: "memory"); __builtin_amdgcn_s_barrier(); asm volatile("" ::: "memory");
            const float* gw = gnw + su1 * DV; const bf16* sgrow = SG + (size_t)su0 * VW + su1 * DV;
#pragma unroll
            for (int ai = 0; ai < 2; ++ai)
#pragma unroll
                for (int m = 0; m < 4; ++m) {
                    const int r = 128 * ai + rbase + 16 * m; const f32x2v st = SR[r];
#pragma unroll
                    for (int hh = 0; hh < 2; ++hh)
#pragma unroll
                        for (int bj = 0; bj < 2; ++bj) {
                            const int c = 256 * hh + 128 * bj + cbase; const size_t o = (size_t)r * VW + c;
                            f32x4 y0, y1; if (hh == 0) ld_bf8(yrow + o, y0, y1); else { y0 = acc[ai][bj][m][0]; y1 = acc[ai][bj][m][1]; }
                            f32x4 g0, g1; ld_bf8(sgrow + o, g0, g1);
                            const f32x4 w0 = *(const f32x4*)(gw + c), w1 = *(const f32x4*)(gw + c + 4);
                            *(v4u*)(yrow + o) = pk8((y0 - st.x) * st.y * w0 * g0, (y1 - st.x) * st.y * w1 * g1);
                        }
                }
            asm volatile("s_waitcnt lgkmcnt(0)" ::: "memory"); __builtin_amdgcn_s_barrier(); asm volatile("" ::: "memory");
        }
        pg8::acc_zero(acc);
    }
};
struct P5Sched {
    int vcu; const char *CBU, *YG, *WCAT;
    __device__ __forceinline__ bool next(int i, pg8::Seg& s) const {
        if (i >= 2) return false;
        const int x = vcu >> 5, j = vcu & 31, pm = 8 * x + (j & 7), pn = j >> 3;
        if (i == 0) { s.A = CBU + (size_t)pm * 256 * DM * 2; s.lda = DM * 2; s.B = WCAT + (size_t)pn * 256 * 3072 * 2; s.nt = 16; s.act = 1; }
        else { s.A = YG + (size_t)pm * 256 * VW * 2; s.lda = VW * 2; s.B = WCAT + ((size_t)pn * 256 * 3072 + 1024) * 2; s.nt = 32; s.act = 2; }
        s.ldb = 3072 * 2; s.u0 = pm; s.u1 = pn; s.u2 = 0; s.u3 = 0; return true;
    }
};
struct P5Epi {
    const bf16 *G1, *G2; bf16* MERGED;
    __device__ __forceinline__ void after(pg8::Acc& acc, const pg8::Seg& s, int wid) const {
        const int lane = lane_id(), wr = wid >> 2, wc = wid & 3, fr = lane & 15, fq = lane >> 4;
        int su0 = s.u0, su1 = s.u1; asm volatile("" : "+s"(su0), "+s"(su1));
        int rbase = 64 * wr + fr, cbase = 32 * wc + 8 * fq; asm volatile("" : "+v"(rbase), "+v"(cbase));
#pragma unroll
        for (int ai = 0; ai < 2; ++ai)
#pragma unroll
            for (int m = 0; m < 4; ++m)
#pragma unroll
                for (int bj = 0; bj < 2; ++bj) {
                    const size_t o = (size_t)(256 * su0 + 128 * ai + rbase + 16 * m) * DM + 256 * su1 + 128 * bj + cbase;
                    f32x4 a0, a1; ld_bf8(G1 + o, a0, a1);
                    if (s.act == 1) { f32x4 b0, b1; ld_bf8(G2 + o, b0, b1);
#pragma unroll
                        for (int e = 0; e < 4; ++e) { acc[ai][bj][m][0][e] *= __fdividef(b0[e], a0[e]); acc[ai][bj][m][1][e] *= __fdividef(b1[e], a1[e]); } }
                    else *(v4u*)(MERGED + o) = pk8(acc[ai][bj][m][0] * a0, acc[ai][bj][m][1] * a1);
                }
    }
};
struct P6Sched {
    int vcu; const char *MERGED, *WOUT;
    __device__ __forceinline__ bool next(int i, pg8::Seg& s) const {
        if (i >= 1) return false;
        const int x = vcu >> 5, j = vcu & 31, pm = 8 * x + (j & 7), pn = j >> 3;
        s.A = MERGED + (size_t)pm * 256 * DM * 2; s.B = WOUT + (size_t)pn * 256 * DM * 2; s.lda = DM * 2; s.ldb = DM * 2; s.nt = 16; s.act = 1; s.u0 = pm; s.u1 = pn; s.u2 = 0; s.u3 = 0; return true;
    }
};
struct P6Epi {
    const float *X, *MOD; float* X1;
    __device__ __forceinline__ void after(pg8::Acc& acc, const pg8::Seg& s, int wid) const {
        const int lane = lane_id(), wr = wid >> 2, wc = wid & 3, fr = lane & 15, fq = lane >> 4;
        int su0 = s.u0, su1 = s.u1; asm volatile("" : "+s"(su0), "+s"(su1));
        int rbase = 64 * wr + fr, cbase = 32 * wc + 8 * fq; asm volatile("" : "+v"(rbase), "+v"(cbase));
        const float* g = MOD + ((256 * su0) / SEQ) * 6144 + 2048;
#pragma unroll
        for (int ai = 0; ai < 2; ++ai)
#pragma unroll
            for (int m = 0; m < 4; ++m)
#pragma unroll
                for (int bj = 0; bj < 2; ++bj)
#pragma unroll
                    for (int n = 0; n < 2; ++n) {
                        const int c = 256 * su1 + 128 * bj + cbase + 4 * n; const size_t o = (size_t)(256 * su0 + 128 * ai + rbase + 16 * m) * DM + c;
                        *(f32x4*)(X1 + o) = *(const f32x4*)(X + o) + *(const f32x4*)(g + c) * acc[ai][bj][m][n];
                    }
    }
};
struct MoeSched {
    int vcu, ntile, which; const char *A, *B; const LAS int* eoff;
    __device__ __forceinline__ bool next(int i, pg8::Seg& s) const {
        const int u = vcu + 256 * i; if (u >= ntile * 4) return false;
        const int mt = u >> 2, pn = u & 3; int e = 0;
#pragma unroll
        for (int q = 1; q < NE; ++q) e += (mt * 256 >= eoff[q]) ? 1 : 0;
        e = __builtin_amdgcn_readfirstlane(e);
        if (which == 0) { s.A = A + (size_t)mt * 256 * DM * 2; s.B = B + ((size_t)e * 1024 + pn * 256) * DM * 2; s.lda = DM * 2; s.ldb = DM * 2; s.nt = 16; }
        else { s.A = A + (size_t)mt * 256 * EH * 2; s.B = B + ((size_t)e * DM + pn * 256) * EH * 2; s.lda = EH * 2; s.ldb = EH * 2; s.nt = 8; }
        s.act = 1 + which; s.u0 = mt; s.u1 = pn; s.u2 = 0; s.u3 = 0; return true;
    }
};
struct MoeEpi {
    bf16 *ACT, *YB; const float* SLOTW;
    __device__ __forceinline__ void after(pg8::Acc& acc, const pg8::Seg& s, int wid) const {
        const int lane = lane_id(), wr = wid >> 2, wc = wid & 3, fr = lane & 15, fq = lane >> 4;
        int su0 = s.u0, su1 = s.u1; asm volatile("" : "+s"(su0), "+s"(su1));
        int rbase = 64 * wr + fr, cbase = 32 * wc + 8 * fq; asm volatile("" : "+v"(rbase), "+v"(cbase));
#pragma unroll
        for (int ai = 0; ai < 2; ++ai)
#pragma unroll
            for (int m = 0; m < 4; ++m) {
                const int row = 256 * su0 + 128 * ai + rbase + 16 * m;
                if (s.act == 1) {
                    f32x4 o[2];
#pragma unroll
                    for (int n = 0; n < 2; ++n)
#pragma unroll
                        for (int e = 0; e < 4; ++e) o[n][e] = siluf(acc[ai][0][m][n][e]) * acc[ai][1][m][n][e];
                    *(v4u*)(ACT + (size_t)row * EH + 128 * su1 + cbase) = pk8(o[0], o[1]);
                } else {
                    const float cw = SLOTW[row];
#pragma unroll
                    for (int bj = 0; bj < 2; ++bj) *(v4u*)(YB + (size_t)row * DM + 256 * su1 + 128 * bj + cbase) = pk8(acc[ai][bj][m][0] * cw, acc[ai][bj][m][1] * cw);
                }
            }
        pg8::acc_zero(acc);
    }
};

__global__ void __launch_bounds__(NTHREADS, 2) fwd_kernel(Params P) {
    extern __shared__ __attribute__((aligned(16))) unsigned char lds_raw[];
    Ctx C;
    C.lds = (LAS unsigned char*)lds_raw;
    C.tid = threadIdx.x; C.lane = C.tid & 63; C.wave = __builtin_amdgcn_readfirstlane(C.tid >> 6);
    C.gw = blockIdx.x * NWAVES + C.wave; C.ngw = gridDim.x * NWAVES;
    int lane = C.lane, tid = C.tid;
    unsigned char* ws = P.ws; unsigned char* wsb = ws; float* outb = P.out;
    unsigned* ctl = (unsigned*)(ws + WS_CTL);
    volatile LAS unsigned* MISC = (volatile LAS unsigned*)(C.lds + LDS_MISC);
    if (tid < 64) MISC[tid] = 0u;
    __syncthreads();
    XcdBarrier bar = xcd_barrier_post(ctl + CW_BAR, MISC + 8);
#define GRID_BAR() do { xcd_barrier(bar); lane = lane_id(); tid = C.wave * 64 + lane; C.tid = tid; C.lane = lane; wsb = P.ws; outb = P.out; asm volatile("" : "+s"(wsb), "+s"(outb)); } while (0)
    const int vcu = (int)((blockIdx.x & 7) * (gridDim.x >> 3) + (blockIdx.x >> 3));

#define MOD ((float*)((float*)(wsb + WS_SMALL + SM_MOD)))
#define ROPE_C ((float*)((float*)(wsb + WS_SMALL + SM_ROPE)))
#define ROPE_S ((float*)(ROPE_C + 4096))
#define ROPE_CT ((float*)(ROPE_C + 8192))
#define ROPE_ST ((float*)(ROPE_C + 12288))
#define DEC ((float*)((float*)(wsb + WS_SMALL + SM_DEC)))
#define TOKE ((int*)((int*)(wsb + WS_SMALL + SM_TOKE)))
#define TOKP ((int*)((int*)(wsb + WS_SMALL + SM_TOKP)))
#define TOKW ((float*)((float*)(wsb + WS_SMALL + SM_TOKW)))
#define TOKS ((int*)((int*)(wsb + WS_SMALL + SM_TOKS)))
#define SLOTW ((float*)((float*)(wsb + WS_SMALL + SM_SLOTW)))
#define WCAT ((bf16*)((bf16*)(wsb + WS_WCAT)))
#define WOUT ((bf16*)((bf16*)(wsb + WS_WOUT)))
#define WRT ((bf16*)(wsb + WS_WR))
#define CBU ((bf16*)((bf16*)(wsb + WS_CBU)))
#define SG ((bf16*)((bf16*)(wsb + WS_SG)))
#define ACAT ((bf16*)((bf16*)(wsb + WS_ACAT)))
#define KB ((bf16*)((bf16*)(wsb + WS_KB)))
#define KTF ((bf16*)((bf16*)(wsb + WS_KT)))
#define KTB ((bf16*)(KTF + (size_t)QKW * TP))
#define VT ((bf16*)((bf16*)(wsb + WS_VT)))
#define STF ((bf16*)((bf16*)(wsb + WS_ST)))
#define STB ((bf16*)(STF + (size_t)VW * TP))
#define HX ((bf16*)((bf16*)(wsb + WS_HX)))
#define WIN ((bf16*)((bf16*)(wsb + WS_WIN)))
#define TMPCCH ((bf16*)((bf16*)(wsb + WS_TMPCCH)))
#define YG ((bf16*)((bf16*)(wsb + WS_YG)))
#define MERGED ((bf16*)((bf16*)(wsb + WS_MERGED)))
#define HX2 ((bf16*)((bf16*)(wsb + WS_HX2)))
#define WE13 ((bf16*)((bf16*)(wsb + WS_WE13)))
#define WE2 ((bf16*)((bf16*)(wsb + WS_WE2)))
#define ACT ((bf16*)((bf16*)(wsb + WS_ACT)))
#define XS ((bf16*)((bf16*)(wsb + WS_XS)))
#define HID ((bf16*)((bf16*)(wsb + WS_HID)))
#define YB ((bf16*)((bf16*)(wsb + WS_Y)))
#define G1 ((bf16*)((bf16*)outb))
#define G2 ((bf16*)(G1 + (size_t)T * DM))
#define X1 ((float*)(outb))
    LAS float* scr = (LAS float*)(C.lds + C.wave * 16384);

    {
        const float* wmod = P.in[I_WMOD];
        LAS float* red = (LAS float*)(C.lds + LDS_EPI);
        for (int it = blockIdx.x; it < 192; it += gridDim.x) {
            const int cg = lane & 7, kr = lane >> 3;
            f32x4 a[5];
#pragma unroll
            for (int r = 0; r < 5; ++r) a[r] = (f32x4){0.f, 0.f, 0.f, 0.f};
            for (int i = 0; i < 16; ++i) {
                const int k = C.wave * 128 + i * 8 + kr;
                const f32x4 w4 = *(const f32x4*)(wmod + (size_t)k * 6144 + it * 32 + cg * 4);
#pragma unroll
                for (int r = 0; r < 5; ++r) { const float cv = r < 4 ? P.in[I_C][r * DM + k] : P.in[I_CCTX][k]; a[r] += w4 * siluf(cv); }
            }
#pragma unroll
            for (int r = 0; r < 5; ++r)
#pragma unroll
                for (int e = 0; e < 4; ++e) { float v = a[r][e]; v += __shfl_xor(v, 8); v += __shfl_xor(v, 16); v += __shfl_xor(v, 32); a[r][e] = v; }
            if (kr == 0) {
#pragma unroll
                for (int r = 0; r < 5; ++r)
#pragma unroll
                    for (int e = 0; e < 4; ++e) red[(C.wave * 5 + r) * 32 + cg * 4 + e] = a[r][e];
            }
            __syncthreads();
            if (tid < 160) { const int r = tid >> 5, col = tid & 31; float s = 0.f;
#pragma unroll
                for (int w = 0; w < 8; ++w) s += red[(w * 5 + r) * 32 + col];
                MOD[r * 6144 + it * 32 + col] = s + P.in[I_BMOD][it * 32 + col]; }
            __syncthreads();
        }
        for (int it = C.gw; it < 16 * (PROJ_W / 32); it += C.ngw) {
            const int kb = it & 15, rb = it >> 4;
            transpose_item(P.in[I_WIN], PROJ_W, kb * 64, win_src(rb * 32 + (lane & 31)), WIN + (size_t)(rb * 32) * DM + kb * 64, DM, scr, lane);
        }
        if (blockIdx.x == gridDim.x - 1) {
            for (int i = tid; i < 4096; i += NTHREADS) { const int pos = i >> 6, f = i & 63;
                const float inv = powf(10000.0f, -(float)f / 64.0f), ang = (float)pos * inv;
                const float cv = cosf(ang), sv = sinf(ang); ROPE_C[i] = cv; ROPE_S[i] = sv; ROPE_CT[f * 64 + pos] = cv; ROPE_ST[f * 64 + pos] = sv; }
            if (tid < 8) { const float ld = P.in[I_DECAY][tid]; DEC[tid] = log1pf(-expf(ld)) * 1.4426950408889634f; }
        }
    }
    GRID_BAR();
    {
        for (int row = C.gw; row < TP; row += C.ngw) {
            const bool isx = row < T; const int mr = isx ? row / SEQ : 4;
            const float* xr = isx ? P.in[I_X] + (size_t)row * DM : P.in[I_CTX] + (size_t)(row - T) * DM;
            f32x4 v[4]; float s2 = 0.f;
#pragma unroll
            for (int j = 0; j < 4; ++j) { v[j] = *(const f32x4*)(xr + 256 * j + 4 * lane); s2 += v[j][0] * v[j][0] + v[j][1] * v[j][1] + v[j][2] * v[j][2] + v[j][3] * v[j][3]; }
            const float rstd = rsqrtf(wave_sum(s2) * (1.f / DM) + 1e-6f);
#pragma unroll
            for (int j = 0; j < 4; ++j) { const int c = 256 * j + 4 * lane;
                const f32x4 w = *(const f32x4*)(P.in[I_N1W] + c), sh = *(const f32x4*)(MOD + mr * 6144 + c), sc = *(const f32x4*)(MOD + mr * 6144 + 1024 + c);
                const f32x4 o = (v[j] * rstd * w) * (sc + 1.f) + sh;
                st_bf4(HX + (size_t)row * DM + c, o); }
        }
        for (int i = C.gw * 64 + lane; i < 48 * DM; i += C.ngw * 64) { const int r = i >> 10, k = i & 1023;
            const float v = r < 4 ? P.in[I_RGW][k * 4 + r] : r < 36 ? P.in[I_REW][k * 32 + (r - 4)] : 0.f; WRT[i] = (bf16)f2bf(v); }
        for (int it = C.gw; it < (16 + 32 + 16) * 32; it += C.ngw) {
            const int rb = it & 31; int kb = it >> 5;
            if (kb < 16) transpose_item(P.in[I_WCONVO], DM, kb * 64, rb * 32 + (lane & 31), WCAT + (size_t)(rb * 32) * 3072 + kb * 64, 3072, scr, lane);
            else if (kb < 48) { kb -= 16; transpose_item(P.in[I_WRETO], DM, kb * 64, rb * 32 + (lane & 31), WCAT + (size_t)(rb * 32) * 3072 + 1024 + kb * 64, 3072, scr, lane); }
            else { kb -= 48; transpose_item(P.in[I_WOUT], DM, kb * 64, rb * 32 + (lane & 31), WOUT + (size_t)(rb * 32) * DM + kb * 64, DM, scr, lane); }
        }
    }
    GRID_BAR();
#if FAST_P2
    {
        P2Sched S{vcu, (const char*)HX, (const char*)WIN};
        P2Epi E{ACAT, KB, KTF, KTB, VT, SG, CBU, G1, G2, ROPE_C, ROPE_S, ROPE_CT, ROPE_ST, DEC, P.in[I_CONVW]};
        pg8::gemm_stream(C.lds, C.wave, S, E);
    }
    GRID_BAR();
#else
    {
        auto rope4 = [&](f32x4 v, int p, int n) -> f32x4 {
            const int half = p >> 7, i0 = (p & 127) >> 1, pos = half ? (n & 63) : (n >> 6);
            const float c0 = ROPE_C[pos * 64 + i0], s0 = ROPE_S[pos * 64 + i0], c1 = ROPE_C[pos * 64 + i0 + 1], s1 = ROPE_S[pos * 64 + i0 + 1];
            return (f32x4){v[0] * c0 - v[1] * s0, v[0] * s0 + v[1] * c0, v[2] * c1 - v[3] * s1, v[2] * s1 + v[3] * c1};
        };
        ngemm(C, HX, DM, WIN + (size_t)R_Q * DM, DM, T, QKW, DM, [&](int t, int col, f32x4 v) {
            const int h = col >> 8, p = col & 255, n = t & (SEQ - 1), i = n & (CH - 1);
            const f32x4 o = rope4(v, p, n);
            const float xf = exp2f(DEC[h] * (float)(i + 1)), xb = exp2f(DEC[4 + h] * (float)(CH - i));
            bf16* dst = ACAT + ((size_t)h * T + t) * 768 + p;
            st_bf4(dst + 256, o * xf); st_bf4(dst + 512, o * xb);
        });
        ngemm(C, HX, DM, WIN + (size_t)R_K * DM, DM, T, QKW, DM, [&](int t, int col, f32x4 v) {
            const int p = col & 255, n = t & (SEQ - 1);
            st_bf4(KB + (size_t)t * QKW + col, rope4(v, p, n) * 0.0625f);
        });
        ngemm(C, WIN + (size_t)R_K * DM, DM, HX, DM, QKW, TP, DM, [&](int row, int tc, f32x4 v) {
            const int h = row >> 8, p = row & 255;
            f32x4 o = v;
            f32x4 pr; pr[0] = __shfl_xor(v[0], 1); pr[1] = __shfl_xor(v[1], 1); pr[2] = __shfl_xor(v[2], 1); pr[3] = __shfl_xor(v[3], 1);
            int j0;
            if (tc < T) {
                const int n0 = tc & (SEQ - 1), half = p >> 7, fi = (p & 127) >> 1;
#pragma unroll
                for (int e = 0; e < 4; ++e) { const int n = n0 + e, pos = half ? (n & 63) : (n >> 6);
                    const float cs = ROPE_C[pos * 64 + fi], sn = ROPE_S[pos * 64 + fi];
                    o[e] = (p & 1) ? (pr[e] * sn + v[e] * cs) : (v[e] * cs - pr[e] * sn); }
                j0 = n0 & (CH - 1);
            } else j0 = (tc - T) & (CTXL - 1);
            f32x4 of, ob;
#pragma unroll
            for (int e = 0; e < 4; ++e) { const float kk = o[e] * 0.0625f; of[e] = kk * exp2f(DEC[h] * (float)(CH - 1 - (j0 + e))); ob[e] = kk * exp2f(DEC[4 + h] * (float)(j0 + e)); }
            st_bf4(KTF + (size_t)row * TP + tc, of); st_bf4(KTB + (size_t)row * TP + tc, ob);
        });
        ngemm(C, WIN + (size_t)R_V * DM, DM, HX, DM, VW, TP, DM, [&](int row, int tc, f32x4 v) { st_bf4(VT + (size_t)row * TP + tc, v); });
        ngemm(C, HX, DM, WIN + (size_t)R_G * DM, DM, T, VW, DM, [&](int t, int col, f32x4 v) {
            st_bf4(SG + (size_t)t * VW + col, (f32x4){siluf(v[0]), siluf(v[1]), siluf(v[2]), siluf(v[3])}); });
        ngemm(C, HX, DM, WIN + (size_t)R_CB * DM, DM, T, DM, DM, [&](int t, int col, f32x4 v) { st_bf4(CBU + (size_t)t * DM + col, v); });
        ngemm(C, HX, DM, WIN + (size_t)R_CCH * DM, DM, T, 2048, DM, [&](int t, int col, f32x4 v) {
            const int g = col >> 8, w = col & 255, isch = w >> 7, chn = g * 128 + (w & 127);
            st_bf4(TMPCCH + (size_t)t * 2048 + isch * 1024 + chn, v); });
        ngemm(C, HX, DM, WIN + (size_t)R_GATE * DM, DM, T, 2048, DM, [&](int t, int col, f32x4 v) {
            const f32x4 o = (f32x4){sigm(v[0]), sigm(v[1]), sigm(v[2]), sigm(v[3])};
            if (col < DM) st_bf4(G1 + (size_t)t * DM + col, o); else st_bf4(G2 + (size_t)t * DM + col - DM, o); });
    }
    GRID_BAR();
    {
        const float* cw = P.in[I_CONVW];
        for (int it = C.gw * 64 + lane; it < T * (DM / 4); it += C.ngw * 64) {
            const int t = it >> 8, c = (it & 255) * 4, colp = t & 63;
            f32x4 u = (f32x4){0.f, 0.f, 0.f, 0.f};
#pragma unroll
            for (int j = 0; j < 3; ++j) { const int cp = colp + j - 1;
                if (cp >= 0 && cp < 64) { const size_t tt = (size_t)(t + j - 1) * 2048;
                    u += ld_bf4(TMPCCH + tt + c) * ld_bf4(TMPCCH + tt + 1024 + c) * *(const f32x4*)(cw + j * DM + c); } }
            bf16* d = CBU + (size_t)t * DM + c;
            st_bf4(d, ld_bf4(d) * u);
        }
    }
    GRID_BAR();
#endif
#if FAST_P3
    {
        if (vcu < 64) { P3Sched<0> S{vcu, (const char*)VT, (const char*)KTF, (const char*)KTB, (const char*)ACAT, (const char*)KB}; P3Epi<0> E{STF, STB, ACAT, DEC}; pg8::gemm_stream(C.lds, C.wave, S, E); }
        else { P3Sched<1> S{vcu, (const char*)VT, (const char*)KTF, (const char*)KTB, (const char*)ACAT, (const char*)KB}; P3Epi<1> E{STF, STB, ACAT, DEC}; pg8::gemm_stream(C.lds, C.wave, S, E); }
    }
    GRID_BAR();
#else
    {
        for (int t = C.gw; t < NB * NCH * NH * 16; t += C.ngw) {
            const int prob = t >> 4, sub = t & 15, h = prob & 3, bc = prob >> 2, t0 = bc * CH;
            const int m0 = (sub >> 2) * 64, n0 = (sub & 3) * 64, fr = lane & 15, fq = lane >> 4;
            f32x4 acc[4][4]; acc_zero(acc);
            bf16* Ah = ACAT + ((size_t)h * T + t0) * 768;
            const NSeg sg[1] = {{Ah + 256, KB + (size_t)t0 * QKW + h * DK, 768, QKW, DK}};
            ngemm_acc<1>(acc, sg, m0, n0, lane);
            const float lf = DEC[h], lb = DEC[4 + h];
#pragma unroll
            for (int i = 0; i < 4; ++i)
#pragma unroll
                for (int j = 0; j < 4; ++j) { const int ii = m0 + 16 * i + fr, jj = n0 + 16 * j + 4 * fq; f32x4 o;
#pragma unroll
                    for (int e = 0; e < 4; ++e) { const int jc = jj + e;
                        const float m = jc <= ii ? exp2f(-lf * (float)(jc + 1)) : exp2f(lb * (float)(jc - ii) - lf * (float)(ii + 1));
                        o[e] = acc[i][j][e] * m; }
                    st_bf4(Ah + (size_t)ii * 768 + jj, o); }
        }
        for (int t = C.gw; t < NB * NH * 2 * 32; t += C.ngw) {
            const int tile = t & 31, dir = (t >> 5) & 1, h = (t >> 6) & 3, b = t >> 8;
            const int m0 = (tile >> 2) * 64, n0 = (tile & 3) * 64, fr = lane & 15, fq = lane >> 4;
            const bf16* Av = VT + (size_t)(h * DV) * TP; const bf16* Bk = (dir ? KTB : KTF) + (size_t)(h * DK) * TP;
            bf16* ST = (dir ? STB : STF) + (size_t)(h * DV) * TP;
            const float dec = exp2f(DEC[dir * 4 + h] * (float)CH);
            f32x4 acc[4][4]; acc_zero(acc);
            for (int s = 0; s < NCH; ++s) {
                const int tc0 = s == 0 ? T + b * CTXL : b * SEQ + (dir ? (NCH - s) : (s - 1)) * CH;
                const NSeg sg[1] = {{Av + tc0, Bk + tc0, TP, TP, CH}};
                ngemm_acc<1>(acc, sg, m0, n0, lane);
                const int dc = b * SEQ + (dir ? (NCH - 1 - s) : s) * CH;
#pragma unroll
                for (int i = 0; i < 4; ++i)
#pragma unroll
                    for (int j = 0; j < 4; ++j) { st_bf4(ST + (size_t)(m0 + 16 * i + fr) * TP + dc + n0 + 16 * j + 4 * fq, acc[i][j]); acc[i][j] = acc[i][j] * dec; }
            }
        }
    }
    GRID_BAR();
#endif
#if FAST_P4
    {
        P4Sched S{vcu, (const char*)wsb};
        P4Epi E{YG, SG, P.in[I_GNW], C.lds};
        pg8::gemm_stream(C.lds, C.wave, S, E);
    }
    GRID_BAR();
#else
    {
        for (int t = C.gw; t < NB * NCH * NH * 32; t += C.ngw) {
            const int prob = t >> 5, sub = t & 31, h = prob & 3, bc = prob >> 2, t0 = bc * CH;
            const int m0 = (sub >> 3) * 64, n0 = (sub & 7) * 64, fr = lane & 15, fq = lane >> 4;
            f32x4 acc[4][4]; acc_zero(acc);
            const bf16* Ah = ACAT + ((size_t)h * T + t0) * 768;
            const size_t bo = (size_t)(h * DV) * TP + t0;
            const NSeg sg[3] = {{Ah, VT + bo, 768, TP, CH}, {Ah + 256, STF + bo, 768, TP, DK}, {Ah + 512, STB + bo, 768, TP, DK}};
            ngemm_acc<3>(acc, sg, m0, n0, lane);
#pragma unroll
            for (int i = 0; i < 4; ++i)
#pragma unroll
                for (int j = 0; j < 4; ++j) st_bf4(YG + (size_t)(t0 + m0 + 16 * i + fr) * VW + h * DV + n0 + 16 * j + 4 * fq, acc[i][j]);
        }
    }
    GRID_BAR();
    {
        const float* gnw = P.in[I_GNW];
        for (int r = C.gw; r < T * NH; r += C.ngw) {
            const int t = r >> 2, h = r & 3; bf16* yp = YG + (size_t)t * VW + h * DV + lane * 8;
            const f32x4 a = ld_bf4(yp), b = ld_bf4(yp + 4);
            const float mu = wave_sum((a[0] + a[1]) + (a[2] + a[3]) + (b[0] + b[1]) + (b[2] + b[3])) * (1.f / DV);
            const f32x4 da = a - mu, db = b - mu;
            const float var = wave_sum(da[0] * da[0] + da[1] * da[1] + da[2] * da[2] + da[3] * da[3] + db[0] * db[0] + db[1] * db[1] + db[2] * db[2] + db[3] * db[3]) * (1.f / DV);
            const float rstd = rsqrtf(var + 1e-5f);
            const float* gw = gnw + h * DV + lane * 8; const bf16* sg = SG + (size_t)t * VW + h * DV + lane * 8;
            st_bf4(yp, da * rstd * *(const f32x4*)gw * ld_bf4(sg));
            st_bf4(yp + 4, db * rstd * *(const f32x4*)(gw + 4) * ld_bf4(sg + 4));
        }
    }
    GRID_BAR();
#endif
#if FAST_P5
    {
        P5Sched S{vcu, (const char*)CBU, (const char*)YG, (const char*)WCAT};
        P5Epi E{G1, G2, MERGED};
        pg8::gemm_stream(C.lds, C.wave, S, E);
    }
    GRID_BAR();
#else
    ngemm(C, CBU, DM, WCAT, 3072, T, DM, DM, [&](int t, int col, f32x4 v) { const size_t o = (size_t)t * DM + col; st_bf4(MERGED + o, v * ld_bf4(G2 + o)); });
    GRID_BAR();
    ngemm(C, YG, VW, WCAT + 1024, 3072, T, DM, VW, [&](int t, int col, f32x4 v) { const size_t o = (size_t)t * DM + col; st_bf4(MERGED + o, v * ld_bf4(G1 + o) + ld_bf4(MERGED + o)); });
    GRID_BAR();
#endif
#if FAST_P6
    {
        P6Sched S{vcu, (const char*)MERGED, (const char*)WOUT};
        P6Epi E{P.in[I_X], MOD, X1};
        pg8::gemm_stream(C.lds, C.wave, S, E);
    }
    GRID_BAR();
#else
    ngemm(C, MERGED, DM, WOUT, DM, T, DM, DM, [&](int t, int col, f32x4 v) {
        const size_t o = (size_t)t * DM + col; const int b = t / SEQ;
        *(f32x4*)(X1 + o) = *(const f32x4*)(P.in[I_X] + o) + *(const f32x4*)(MOD + b * 6144 + 2048 + col) * v; });
    GRID_BAR();
#endif
    {
        for (int row = C.gw; row < T; row += C.ngw) {
            const int mr = row / SEQ; const float* xr = X1 + (size_t)row * DM;
            f32x4 v[4]; float s2 = 0.f;
#pragma unroll
            for (int j = 0; j < 4; ++j) { v[j] = *(const f32x4*)(xr + 256 * j + 4 * lane); s2 += v[j][0] * v[j][0] + v[j][1] * v[j][1] + v[j][2] * v[j][2] + v[j][3] * v[j][3]; }
            const float rstd = rsqrtf(wave_sum(s2) * (1.f / DM) + 1e-6f);
#pragma unroll
            for (int j = 0; j < 4; ++j) { const int c = 256 * j + 4 * lane;
                const f32x4 w = *(const f32x4*)(P.in[I_N2W] + c), sh = *(const f32x4*)(MOD + mr * 6144 + 3072 + c), sc = *(const f32x4*)(MOD + mr * 6144 + 4096 + c);
                st_bf4(HX2 + (size_t)row * DM + c, (v[j] * rstd * w) * (sc + 1.f) + sh); }
        }
        for (int it = C.gw; it < NE * (16 * 32 + 8 * 32); it += C.ngw) {
            const int e = it / 768, r = it % 768;
            if (r < 512) { const int kb = r & 15, rb = r >> 4, rho = rb * 32 + (lane & 31), g = rho >> 8, w = rho & 255;
                transpose_item(P.in[I_W13] + (size_t)e * DM * 1024, 1024, kb * 64, w < 128 ? g * 128 + w : 512 + g * 128 + (w - 128), WE13 + ((size_t)e * 1024 + rb * 32) * DM + kb * 64, DM, scr, lane); }
            else { const int r2 = r - 512, kb = r2 & 7, rb = r2 >> 3;
                transpose_item(P.in[I_W2] + (size_t)e * EH * DM, DM, kb * 64, rb * 32 + (lane & 31), WE2 + ((size_t)e * DM + rb * 32) * EH + kb * 64, EH, scr, lane); }
        }
    }
    GRID_BAR();
    {
        LAS float* lg = (LAS float*)(C.lds + C.wave * 16384);
        const int fr = lane & 15, fq = lane >> 4;
        for (int tb = C.gw; tb < T / 16; tb += C.ngw) {
            f32x4 acc3[3];
#pragma unroll
            for (int j = 0; j < 3; ++j) acc3[j] = (f32x4){0.f, 0.f, 0.f, 0.f};
            const bf16* ap = HX2 + (size_t)(tb * 16 + fr) * DM + 8 * fq; const bf16* bp = WRT + (size_t)fr * DM + 8 * fq;
#pragma unroll 4
            for (int k0 = 0; k0 < DM; k0 += 32) {
                const bf16x8 a = *(const bf16x8*)(ap + k0);
#pragma unroll
                for (int j = 0; j < 3; ++j) acc3[j] = __builtin_amdgcn_mfma_f32_16x16x32_bf16(*(const bf16x8*)(bp + (size_t)j * 16 * DM + k0), a, acc3[j], 0, 0, 0);
            }
#pragma unroll
            for (int j = 0; j < 3; ++j) *(LAS f32x4*)(lg + fr * 48 + 16 * j + 4 * fq) = acc3[j];
            LDS_WAIT(); asm volatile("" ::: "memory");
            if (lane < 16) {
                const int t = tb * 16 + lane; const LAS float* l = lg + lane * 48;
                float gl[4];
#pragma unroll
                for (int g = 0; g < 4; ++g) gl[g] = l[g] + P.in[I_RGB][g];
                int gi = 0; float gm = gl[0];
#pragma unroll
                for (int g = 1; g < 4; ++g) if (gl[g] > gm) { gm = gl[g]; gi = g; }
                float gs = 0.f;
#pragma unroll
                for (int g = 0; g < 4; ++g) gs += __expf(gl[g] - gm);
                const float gwt = 1.f / gs;
                float el[8];
#pragma unroll
                for (int j = 0; j < 8; ++j) el[j] = l[4 + gi * 8 + j] + P.in[I_REB][gi * 8 + j];
                int i1 = 0; float m1 = el[0];
#pragma unroll
                for (int j = 1; j < 8; ++j) if (el[j] > m1) { m1 = el[j]; i1 = j; }
                int i2 = -1; float m2 = -3.0e38f;
#pragma unroll
                for (int j = 0; j < 8; ++j) if (j != i1 && el[j] > m2) { m2 = el[j]; i2 = j; }
                const float e2 = __expf(m2 - m1), w1 = 1.f / (1.f + e2), w2 = e2 * w1;
                const int ea = gi * 8 + i1, eb = gi * 8 + i2;
                const int pa = (int)atomicAdd(ctl + CW_CNT + ea, 1u), pb = (int)atomicAdd(ctl + CW_CNT + eb, 1u);
                TOKE[t * 2] = ea; TOKE[t * 2 + 1] = eb; TOKP[t * 2] = pa; TOKP[t * 2 + 1] = pb; TOKW[t * 2] = gwt * w1; TOKW[t * 2 + 1] = gwt * w2;
            }
            LDS_WAIT(); asm volatile("" ::: "memory");
        }
    }
    GRID_BAR();
    LAS int* eoff = (LAS int*)(C.lds + LDS_EOFF);
    if (tid < 64) {
        const int c = lane < NE ? (int)__hip_atomic_load(ctl + CW_CNT + lane, __ATOMIC_RELAXED, __HIP_MEMORY_SCOPE_AGENT) : 0;
        int v = (c + 255) & ~255;
#pragma unroll
        for (int o = 1; o < 32; o <<= 1) { const int u = __shfl_up(v, o); if (lane >= o) v += u; }
        if (lane < NE) { eoff[lane + 1] = v; if (lane == 0) eoff[0] = 0; }
    }
    __syncthreads();
    const int nslot = __builtin_amdgcn_readfirstlane(eoff[NE]);
    {
        for (int r = C.gw; r < 2 * T; r += C.ngw) {
            const int t = r >> 1, e = TOKE[r], pos = TOKP[r];
            const int slot = eoff[e] + pos;
            if (lane == 0) { TOKS[r] = slot; SLOTW[slot] = TOKW[r]; }
            const v4u* src = (const v4u*)(HX2 + (size_t)t * DM); v4u* dst = (v4u*)(XS + (size_t)slot * DM);
            dst[lane] = src[lane]; dst[lane + 64] = src[lane + 64];
        }
#pragma unroll 1
        for (int e = 0; e < NE; ++e) {
            const int off = eoff[e], nxt = eoff[e + 1];
            const int c = (int)__hip_atomic_load(ctl + CW_CNT + e, __ATOMIC_RELAXED, __HIP_MEMORY_SCOPE_AGENT);
            for (int r = off + c + C.gw; r < nxt; r += C.ngw) { v4u* dst = (v4u*)(XS + (size_t)r * DM); const v4u z = (v4u){0u, 0u, 0u, 0u}; dst[lane] = z; dst[lane + 64] = z; if (lane == 0) SLOTW[r] = 0.f; }
        }
    }
    GRID_BAR();
#if FAST_MOE
    {
        MoeSched S{vcu, nslot >> 8, 0, (const char*)XS, (const char*)WE13, eoff};
        MoeEpi E{ACT, YB, SLOTW};
        pg8::gemm_stream(C.lds, C.wave, S, E);
    }
    GRID_BAR();
#else
    {
        const int tn = 1024 / 64, nt = (nslot / 64) * tn, fr = lane & 15, fq = lane >> 4;
        for (int t = C.gw; t < nt; t += C.ngw) {
            const int m0 = (t / tn) * 64, n0 = (t % tn) * 64;
            int e = 0;
#pragma unroll
            for (int q = 1; q < NE; ++q) e += (m0 >= eoff[q]) ? 1 : 0;
            f32x4 acc[4][4]; acc_zero(acc);
            const NSeg sg[1] = {{XS, WE13 + (size_t)e * 1024 * DM, DM, DM, DM}};
            ngemm_acc<1>(acc, sg, m0, n0, lane);
#pragma unroll
            for (int i = 0; i < 4; ++i)
#pragma unroll
                for (int j = 0; j < 4; ++j) st_bf4(HID + (size_t)(m0 + 16 * i + fr) * 1024 + n0 + 16 * j + 4 * fq, acc[i][j]);
        }
    }
    GRID_BAR();
    {
        for (int it = C.gw * 64 + lane; it < nslot * (EH / 4); it += C.ngw * 64) {
            const int s = it >> 7, c = (it & 127) * 4, g = c >> 7, w = c & 127;
            const f32x4 h1 = ld_bf4(HID + (size_t)s * 1024 + g * 256 + w), h2 = ld_bf4(HID + (size_t)s * 1024 + g * 256 + 128 + w);
            st_bf4(ACT + (size_t)s * EH + c, (f32x4){siluf(h1[0]) * h2[0], siluf(h1[1]) * h2[1], siluf(h1[2]) * h2[2], siluf(h1[3]) * h2[3]});
        }
    }
    GRID_BAR();
#endif
#if FAST_MOE
    {
        MoeSched S{vcu, nslot >> 8, 1, (const char*)ACT, (const char*)WE2, eoff};
        MoeEpi E{ACT, YB, SLOTW};
        pg8::gemm_stream(C.lds, C.wave, S, E);
    }
    GRID_BAR();
#else
    {
        const int tn = DM / 64, nt = (nslot / 64) * tn, fr = lane & 15, fq = lane >> 4;
        for (int t = C.gw; t < nt; t += C.ngw) {
            const int m0 = (t / tn) * 64, n0 = (t % tn) * 64;
            int e = 0;
#pragma unroll
            for (int q = 1; q < NE; ++q) e += (m0 >= eoff[q]) ? 1 : 0;
            f32x4 acc[4][4]; acc_zero(acc);
            const NSeg sg[1] = {{ACT, WE2 + (size_t)e * DM * EH, EH, EH, EH}};
            ngemm_acc<1>(acc, sg, m0, n0, lane);
#pragma unroll
            for (int i = 0; i < 4; ++i) { const int row = m0 + 16 * i + fr; const float cwt = SLOTW[row];
#pragma unroll
                for (int j = 0; j < 4; ++j) st_bf4(YB + (size_t)row * DM + n0 + 16 * j + 4 * fq, acc[i][j] * cwt); }
        }
    }
    GRID_BAR();
#endif
    {
        for (int row = C.gw; row < T; row += C.ngw) {
            const int mr = row / SEQ; float* xr = X1 + (size_t)row * DM;
            const int s0 = TOKS[row * 2], s1 = TOKS[row * 2 + 1];
            f32x4 v[4]; float s2 = 0.f;
#pragma unroll
            for (int j = 0; j < 4; ++j) { const int c = 256 * j + 4 * lane;
                const f32x4 y = ld_bf4(YB + (size_t)s0 * DM + c) + ld_bf4(YB + (size_t)s1 * DM + c);
                v[j] = *(const f32x4*)(xr + c) + *(const f32x4*)(MOD + mr * 6144 + 5120 + c) * y;
                s2 += v[j][0] * v[j][0] + v[j][1] * v[j][1] + v[j][2] * v[j][2] + v[j][3] * v[j][3]; }
            const float rstd = rsqrtf(wave_sum(s2) * (1.f / DM) + 1e-6f);
#pragma unroll
            for (int j = 0; j < 4; ++j) { const int c = 256 * j + 4 * lane; *(f32x4*)(xr + c) = v[j] * rstd * *(const f32x4*)(P.in[I_FNW] + c); }
        }
    }
}

extern "C" void kernel_launch(void* const* d_in, const int* in_sizes, int n_in, void* d_out, int out_size, void* d_ws, size_t ws_size, hipStream_t stream) {
    static int grid = 0;
    if (grid == 0) {
        if (n_in != 22 || out_size != T * DM || ws_size < WS_END) { fprintf(stderr, "kernel_launch: unexpected problem (n_in %d, out %d, ws %zu, need %zu)\n", n_in, out_size, ws_size, (size_t)WS_END); grid = -1; return; }
        int dev = 0, cus = 0, per_cu = 0;
        if (hipGetDevice(&dev) != hipSuccess || hipDeviceGetAttribute(&cus, hipDeviceAttributeMultiprocessorCount, dev) != hipSuccess) { grid = -1; return; }
        if (hipFuncSetAttribute((const void*)fwd_kernel, hipFuncAttributeMaxDynamicSharedMemorySize, LDS_BYTES) != hipSuccess) { fprintf(stderr, "kernel_launch: hipFuncSetAttribute failed\n"); grid = -1; return; }
        if (hipOccupancyMaxActiveBlocksPerMultiprocessor(&per_cu, (const void*)fwd_kernel, NTHREADS, LDS_BYTES) != hipSuccess || per_cu < 1) { fprintf(stderr, "kernel_launch: occupancy query reports %d\n", per_cu); per_cu = 1; }
        (void)hipGetLastError();
        grid = cus;
    }
    if (grid < 0) return;
    (void)hipMemsetAsync((char*)d_ws + WS_CTL, 0, 1 * MiB, stream);
    Params p{};
    for (int i = 0; i < 22; ++i) p.in[i] = (const float*)d_in[i];
    p.out = (float*)d_out; p.ws = (unsigned char*)d_ws;
    hipLaunchKernelGGL(fwd_kernel, dim3(grid), dim3(NTHREADS), LDS_BYTES, stream, p);
}
```

```cpp
#include <hip/hip_runtime.h>
#include <cstdio>
#include <cstdint>

#define GAS __attribute__((address_space(1)))
#define LAS __attribute__((address_space(3)))
typedef unsigned short bf16;
typedef short bf16x8 __attribute__((ext_vector_type(8)));
typedef float f32x4 __attribute__((ext_vector_type(4)));
typedef unsigned v4u __attribute__((ext_vector_type(4)));
typedef unsigned v2u __attribute__((ext_vector_type(2)));

constexpr int DM = 1024, NB = 4, SEQ = 4096, T = NB * SEQ, CTXL = 256, TCX = NB * CTXL, TP = T + TCX + 128;
constexpr int NH = 4, DK = 256, DV = 512, QKW = NH * DK, VW = NH * DV;
constexpr int CH = 256, NCH = SEQ / CH;
constexpr int PROJ_W = 11264;
constexpr int OFF_Q = 0, OFF_K = 1024, OFF_V = 2048, OFF_G = 4096, OFF_CB = 6144, OFF_CC = 7168, OFF_CH = 8192, OFF_GATE = 9216;
constexpr int R_Q = 0, R_K = 1024, R_V = 2048, R_G = 4096, R_CB = 6144, R_CCH = 7168, R_GATE = 9216;
constexpr int NE = 32, EH = 512;
constexpr int MAXSLOT = 2 * T + NE * 256;

constexpr size_t MiB = 1u << 20;
constexpr size_t WS_CTL = 0;
constexpr size_t WS_SMALL = 1 * MiB;
constexpr size_t SM_MOD = 0;
constexpr size_t SM_ROPE = 128 * 1024;
constexpr size_t SM_DEC = 192 * 1024;
constexpr size_t SM_TOKE = 256 * 1024;
constexpr size_t SM_TOKP = 384 * 1024;
constexpr size_t SM_TOKW = 512 * 1024;
constexpr size_t SM_TOKS = 640 * 1024;
constexpr size_t SM_SLOTW = 768 * 1024;
constexpr size_t SM_HIST = 928 * 1024;
constexpr size_t WS_WCAT = 2 * MiB;
constexpr size_t WS_WOUT = 8 * MiB;
constexpr size_t WS_WR = 10 * MiB;
constexpr size_t WS_CBU = 11 * MiB;
constexpr size_t WS_SG = 43 * MiB;
constexpr size_t WS_ACAT = 107 * MiB;
constexpr size_t WS_KB = 203 * MiB;
constexpr size_t WS_KT = 235 * MiB;
constexpr size_t WS_VT = 304 * MiB;
constexpr size_t WS_ST = 373 * MiB;
constexpr size_t WS_HX = 373 * MiB;
constexpr size_t WS_WIN = 407 * MiB;
constexpr size_t WS_TMPCCH = 429 * MiB;
constexpr size_t WS_END = 510 * MiB;
constexpr size_t WS_YG = 203 * MiB;
constexpr size_t WS_MERGED = 107 * MiB;
constexpr size_t WS_HX2 = 304 * MiB;
constexpr size_t WS_WE13 = 373 * MiB;
constexpr size_t WS_WE2 = 437 * MiB;
constexpr size_t WS_ACT = 469 * MiB;
constexpr size_t WS_XS = 203 * MiB;
constexpr size_t WS_HID = 107 * MiB;
constexpr size_t WS_Y = 11 * MiB;
constexpr int CW_BAR = 4096;
constexpr int CW_CNT = 16384;

#ifndef PROBE_MASK
#define PROBE_MASK 0
#endif
#define REP(k) (1 + ((PROBE_MASK >> (k)) & 1))
constexpr int NWAVES = 8, NTHREADS = 512;
constexpr int LDS_EPI = 131072;
constexpr int LDS_MISC = 147456;
constexpr int LDS_EOFF = 147456 + 256;
constexpr int LDS_BYTES = 147456 + 512;

__device__ __forceinline__ float bf2f(bf16 v) { return __uint_as_float((unsigned)v << 16); }
__device__ __forceinline__ unsigned f2bf(float f) { unsigned u = __float_as_uint(f); return (u + 0x7fffu + ((u >> 16) & 1u)) >> 16; }
typedef float f32x2_t __attribute__((ext_vector_type(2))); typedef __bf16 bf16x2_t __attribute__((ext_vector_type(2)));
__device__ __forceinline__ unsigned pk2(float lo, float hi) { f32x2_t v = {lo, hi}; bf16x2_t b = __builtin_convertvector(v, bf16x2_t); return __builtin_bit_cast(unsigned, b); }
__device__ __forceinline__ float ex2(float x) { return __builtin_amdgcn_exp2f(x); }
__device__ __forceinline__ float sigm(float x) { return __builtin_amdgcn_rcpf(1.f + ex2(x * -1.4426950408889634f)); }
__device__ __forceinline__ float siluf(float x) { return x * sigm(x); }
__device__ __forceinline__ float wave_sum(float v) {
#pragma unroll
    for (int o = 1; o < 64; o <<= 1) v += __shfl_xor(v, o);
    return v;
}
#define LDS_WAIT() asm volatile("s_waitcnt lgkmcnt(0)" ::: "memory")
__device__ __forceinline__ int lane_id() { int l; asm volatile("v_mbcnt_lo_u32_b32 %0, -1, 0\n\tv_mbcnt_hi_u32_b32 %0, -1, %0" : "=v"(l)); return l; }

#define XB_TMO      128
#define XB_XCNT(j)  (256  + 64 * (j))
#define XB_XSUB(j)  (1280 + 64 * (j))
#define XB_XGEN(j)  (2304 + 64 * (j))
#define XB_TOP      3328
#define XB_TOPGEN   3392
#define XCD_BAR_WORDS 3456
#define XB_SPIN_CAP (1u << 18)
__device__ __forceinline__ unsigned xb_ld(unsigned* p)              { return __hip_atomic_load(p, __ATOMIC_RELAXED, __HIP_MEMORY_SCOPE_AGENT); }
__device__ __forceinline__ unsigned xb_add(unsigned* p, unsigned v) { return __hip_atomic_fetch_add(p, v, __ATOMIC_RELAXED, __HIP_MEMORY_SCOPE_AGENT); }
__device__ __forceinline__ unsigned xb_xcc_id() { return (unsigned)__builtin_amdgcn_s_getreg((3 << 11) | 20) & 0xFu; }
#define XB_SPIN(cond, bar) do { unsigned _sp = 0; while (cond) { __builtin_amdgcn_s_sleep(1); \
    if ((++_sp & 255u) == 0u) { if (xb_ld(&(bar)[XB_TMO])) break; if (_sp > XB_SPIN_CAP) { atomicAdd(&(bar)[XB_TMO], 1u); break; } } } } while (0)
struct XcdBarrier { unsigned* bar; unsigned x; volatile LAS unsigned* st; };
__device__ __forceinline__ XcdBarrier xcd_barrier_post(unsigned* bar, volatile LAS unsigned* st) {
    XcdBarrier b; b.bar = bar; b.x = xb_xcc_id(); b.st = st;
    if (threadIdx.x == 0) (void)xb_add(&bar[XB_XCNT(b.x)], 1u);
    return b;
}
__device__ __forceinline__ void xcd_barrier_complete(unsigned* bar, unsigned x, unsigned& nloc, unsigned& nx) {
    const unsigned G = gridDim.x * gridDim.y * gridDim.z;
    unsigned sum, cnt, mine, sp = 0u;
    for (;;) {
        sum = 0u; cnt = 0u; mine = 0u;
#pragma unroll
        for (unsigned j = 0; j < 16; ++j) { const unsigned c = xb_ld(&bar[XB_XCNT(j)]); sum += c; cnt += (c > 0u) ? 1u : 0u; mine = (j == x) ? c : mine; }
        if (sum == G) break;
        __builtin_amdgcn_s_sleep(1);
        if ((++sp & 255u) == 0u) { if (xb_ld(&bar[XB_TMO])) break; if (sp > XB_SPIN_CAP) { atomicAdd(&bar[XB_TMO], 1u); break; } }
    }
    nloc = mine > 0u ? mine : 1u; nx = cnt > 0u ? cnt : 1u;
}
__device__ __forceinline__ void xcd_barrier(const XcdBarrier& b) {
    asm volatile("s_waitcnt vmcnt(0)" ::: "memory");
    __syncthreads();
    if (threadIdx.x == 0) {
        unsigned* bar = b.bar;
        __builtin_amdgcn_s_waitcnt(0);
        unsigned nloc = b.st[0], nx = b.st[1];
        if (nloc == 0u) { xcd_barrier_complete(bar, b.x, nloc, nx); b.st[0] = nloc; b.st[1] = nx; }
        const unsigned old = xb_add(&bar[XB_XSUB(b.x)], 1u);
        const unsigned gen = old / nloc;
        if (old + 1u == (gen + 1u) * nloc) {
            __builtin_amdgcn_fence(__ATOMIC_RELEASE, "agent");
            asm volatile("s_waitcnt vmcnt(0)" ::: "memory");
            const unsigned og = xb_add(&bar[XB_TOP], 1u);
            const unsigned tg = og / nx;
            if (og + 1u == (tg + 1u) * nx) xb_add(&bar[XB_TOPGEN], 1u);
            else XB_SPIN(xb_ld(&bar[XB_TOPGEN]) == tg, bar);
            __builtin_amdgcn_fence(__ATOMIC_ACQUIRE, "agent");
            xb_add(&bar[XB_XGEN(b.x)], 1u);
            asm volatile("s_waitcnt vmcnt(0)" ::: "memory");
        } else {
            XB_SPIN(xb_ld(&bar[XB_XGEN(b.x)]) == gen, bar);
            __builtin_amdgcn_fence(__ATOMIC_ACQUIRE, "agent");
            asm volatile("s_waitcnt vmcnt(0)" ::: "memory");
        }
    }
    __syncthreads();
}

struct Params { const float* in[22]; float* out; unsigned char* ws; };
enum { I_X = 0, I_C, I_CTX, I_CCTX, I_WMOD, I_BMOD, I_N1W, I_N2W, I_WIN, I_DECAY, I_GNW, I_WRETO, I_CONVW, I_WCONVO, I_WOUT, I_RGW, I_RGB, I_REW, I_REB, I_W13, I_W2, I_FNW };

struct Ctx {
    int tid, lane, wave, gw, ngw;
    LAS unsigned char* lds;
};

struct NSeg { const bf16* A; const bf16* B; int lda, ldb, K; };
template <int NS>
__device__ __forceinline__ void ngemm_acc(f32x4 (&acc)[4][4], const NSeg (&sg)[NS], int m0, int n0, int lane) {
    const int fr = lane & 15, fq = lane >> 4;
#pragma unroll
    for (int s = 0; s < NS; ++s) {
        const bf16* Ap = sg[s].A + (size_t)(m0 + fr) * sg[s].lda + 8 * fq;
        const bf16* Bp = sg[s].B + (size_t)(n0 + fr) * sg[s].ldb + 8 * fq;
        const size_t as = (size_t)16 * sg[s].lda, bs = (size_t)16 * sg[s].ldb;
        for (int k0 = 0; k0 < sg[s].K; k0 += 32) {
            bf16x8 a[4], b[4];
#pragma unroll
            for (int i = 0; i < 4; ++i) { a[i] = *(const bf16x8*)(Ap + i * as + k0); b[i] = *(const bf16x8*)(Bp + i * bs + k0); }
#pragma unroll
            for (int i = 0; i < 4; ++i)
#pragma unroll
                for (int j = 0; j < 4; ++j) acc[i][j] = __builtin_amdgcn_mfma_f32_16x16x32_bf16(b[j], a[i], acc[i][j], 0, 0, 0);
        }
    }
}
__device__ __forceinline__ void acc_zero(f32x4 (&acc)[4][4]) {
#pragma unroll
    for (int i = 0; i < 4; ++i)
#pragma unroll
        for (int j = 0; j < 4; ++j) acc[i][j] = (f32x4){0.f, 0.f, 0.f, 0.f};
}
template <class Epi>
__device__ __forceinline__ void ngemm(const Ctx& C, const bf16* A, int lda, const bf16* B, int ldb, int M, int N, int K, Epi epi) {
    const int tn = N / 64, nt = (M / 64) * tn;
    const int fr = C.lane & 15, fq = C.lane >> 4;
    for (int t = C.gw; t < nt; t += C.ngw) {
        const int m0 = (t / tn) * 64, n0 = (t % tn) * 64;
        f32x4 acc[4][4]; acc_zero(acc);
        const NSeg sg[1] = {{A, B, lda, ldb, K}};
        ngemm_acc<1>(acc, sg, m0, n0, C.lane);
#pragma unroll
        for (int i = 0; i < 4; ++i)
#pragma unroll
            for (int j = 0; j < 4; ++j) epi(m0 + 16 * i + fr, n0 + 16 * j + 4 * fq, acc[i][j]);
    }
}
__device__ __forceinline__ void st_bf4(bf16* p, f32x4 v) { v2u w; w.x = pk2(v[0], v[1]); w.y = pk2(v[2], v[3]); *(v2u*)p = w; }
__device__ __forceinline__ f32x4 ld_bf4(const bf16* p) { const v2u w = *(const v2u*)p; return (f32x4){__uint_as_float(w.x << 16), __uint_as_float(w.x & 0xffff0000u), __uint_as_float(w.y << 16), __uint_as_float(w.y & 0xffff0000u)}; }

__device__ __forceinline__ void transpose_item(const float* W, int ldw, int k0, int srccol, bf16* dst0, int dpitch, LAS float* scr, int lane) {
    float tv[32];
#pragma unroll
    for (int i = 0; i < 32; ++i) tv[i] = W[(size_t)(k0 + 2 * i + (lane >> 5)) * ldw + srccol];
#pragma unroll
    for (int i = 0; i < 32; ++i) scr[(2 * i + (lane >> 5)) * 33 + (lane & 31)] = tv[i];
    LDS_WAIT(); asm volatile("" ::: "memory");
    const int c = lane & 7;
#pragma unroll
    for (int j = 0; j < 4; ++j) { const int n = (lane >> 3) + 8 * j; const LAS float* s = scr + (8 * c) * 33 + n;
        v4u o; o.x = pk2(s[0 * 33], s[1 * 33]); o.y = pk2(s[2 * 33], s[3 * 33]); o.z = pk2(s[4 * 33], s[5 * 33]); o.w = pk2(s[6 * 33], s[7 * 33]);
        *(v4u*)(dst0 + (size_t)n * dpitch + 8 * c) = o; }
    LDS_WAIT(); asm volatile("" ::: "memory");
}
__device__ __forceinline__ int win_src(int rho) {
    if (rho < R_V) {
        const int base = rho < R_K ? OFF_Q : OFF_K, r = rho & 1023, h = r >> 8, p = r & 255;
        const int half = p >> 7, pp = p & 127, i = pp >> 1, s = pp & 1;
        return base + h * 256 + half * 128 + s * 64 + i;
    }
    if (rho < R_CCH) return rho;
    if (rho < R_GATE) { const int r = rho - R_CCH, g = r >> 8, w = r & 255; return w < 128 ? OFF_CC + g * 128 + w : OFF_CH + g * 128 + (w - 128); }
    { const int r = rho - R_GATE, g = r >> 8, w = r & 255; return OFF_GATE + (w < 128 ? g * 128 + w : 1024 + g * 128 + (w - 128)); }
}


namespace pg8 {
constexpr int BM = 256, BK = 64, HALF = 128, HTB = HALF * BK * 2, STAGE_BYTES = 8 * HTB;
__device__ __forceinline__ int lds_byte(int r, int c) { const int st = (r >> 4) * 2 + (c >> 5), rr = r & 15, cc = c & 31, ob = rr * 64 + cc * 2; return st * 1024 + (ob ^ (((ob >> 9) & 1) << 5)); }
__device__ __forceinline__ void stage_rc(int b, int& R, int& C) { const int st = b / 1024, sb = b % 1024, swz = sb ^ (((sb >> 9) & 1) << 5); R = (st >> 1) * 16 + swz / 64; C = (st & 1) * 32 + (swz % 64) / 2; }
__device__ __forceinline__ int perm32(int rho) { const int n = rho >> 4, i = rho & 15; return 8 * (i >> 2) + 4 * n + (i & 3); }
struct Seg { const char* A; const char* B; int lda, ldb; int nt; int act; int u0, u1, u2, u3; };
typedef f32x4 Acc[2][2][4][2];
__device__ __forceinline__ void acc_zero(Acc& acc) {
#pragma unroll
    for (int a = 0; a < 2; ++a)
#pragma unroll
        for (int b = 0; b < 2; ++b)
#pragma unroll
            for (int m = 0; m < 4; ++m)
#pragma unroll
                for (int n = 0; n < 2; ++n) acc[a][b][m][n] = (f32x4){0.f, 0.f, 0.f, 0.f};
}
template <class Sched, class Epi>
__device__ __forceinline__ void gemm_stream(LAS unsigned char* lds, int wid, const Sched& S, const Epi& E) {
    const int lane = lane_id(), tid = wid * 64 + lane;
    const int wr = wid >> 2, wc = wid & 3, fr = lane & 15, fq = lane >> 4;
    int R0, C0; stage_rc(tid * 16, R0, C0); const int Rb0 = (R0 & ~31) + perm32(R0 & 31);
    const unsigned ldsw = (unsigned)wid * 1024u;
    const int aoff = lds_byte(wr * 64 + fr, fq * 8), boff = lds_byte(wc * 32 + fr, fq * 8);
    const size_t kstep = (size_t)(BK * 2);
#define PG8_SA(b, h) (((b) * 2 + (h)) * HTB)
#define PG8_SB(b, h) ((4 + (b) * 2 + (h)) * HTB)
#define PG8_STAGE(bufoff, gbase, voff, rs) do { _Pragma("unroll") for (int _i = 0; _i < 2; ++_i) { const char* _p = (const char*)(gbase) + (size_t)_i * 64 * (rs); asm volatile("" : "+s"(_p));   \
        __builtin_amdgcn_global_load_lds((const unsigned*)(_p + (voff)), (LAS unsigned*)(lds + (bufoff) + ldsw + _i * 8192), 16, 0, 0); } } while (0)
#define PG8_LDA(dst, b, h) do { _Pragma("unroll") for (int m = 0; m < 4; ++m) _Pragma("unroll") for (int k = 0; k < 2; ++k) dst[m][k] = *(const LAS bf16x8*)(lds + PG8_SA(b, h) + aoff + m * 2048 + k * 1024); } while (0)
#define PG8_LDB(dst, b, h) do { _Pragma("unroll") for (int n = 0; n < 2; ++n) _Pragma("unroll") for (int k = 0; k < 2; ++k) dst[n][k] = *(const LAS bf16x8*)(lds + PG8_SB(b, h) + boff + n * 2048 + k * 1024); } while (0)
#define PG8_MMA(ai, bj, At, Bt) do { __builtin_amdgcn_s_setprio(1); _Pragma("unroll") for (int m = 0; m < 4; ++m) _Pragma("unroll") for (int n = 0; n < 2; ++n) _Pragma("unroll") for (int k = 0; k < 2; ++k) \
        acc[ai][bj][m][n] = __builtin_amdgcn_mfma_f32_16x16x32_bf16(Bt[n][k], At[m][k], acc[ai][bj][m][n], 0, 0, 0); __builtin_amdgcn_s_setprio(0); } while (0)
#define PG8_WAIT_V(n) asm volatile("s_waitcnt vmcnt(" #n ")" ::: "memory")
#define PG8_WAIT_L(n) asm volatile("s_waitcnt lgkmcnt(" #n ")" ::: "memory")
#define PG8_BAR __builtin_amdgcn_s_barrier()
#define PG8_SCHED __builtin_amdgcn_sched_barrier(0)
    Seg cur, nxt; int si = 0;
    if (!S.next(0, cur)) return;
    Acc acc; acc_zero(acc);
    bf16x8 At[4][2], B0[2][2], B1[2][2];
    int rsA = cur.lda, rsB = cur.ldb;
    unsigned vA = (unsigned)(R0 * rsA + C0 * 2), vB = (unsigned)(Rb0 * rsB + C0 * 2);
    size_t hsA = (size_t)HALF * rsA, hsB = (size_t)HALF * rsB;
    const char* cA = cur.A; const char* cB = cur.B;
    PG8_STAGE(PG8_SB(0, 0), cB, vB, rsB); PG8_STAGE(PG8_SB(0, 1), cB + hsB, vB, rsB); PG8_STAGE(PG8_SA(0, 0), cA, vA, rsA); PG8_STAGE(PG8_SA(0, 1), cA + hsA, vA, rsA);
    if (wr == 1) PG8_BAR;
    PG8_WAIT_V(2); PG8_BAR;
    PG8_STAGE(PG8_SB(1, 0), cB + kstep, vB, rsB); PG8_STAGE(PG8_SA(1, 0), cA + kstep, vA, rsA); PG8_STAGE(PG8_SB(1, 1), cB + hsB + kstep, vB, rsB);
    PG8_WAIT_V(6); PG8_BAR;
    for (;;) {
        const bool has_next = S.next(si + 1, nxt);
        const char* nA = has_next ? nxt.A : cA; const char* nB = has_next ? nxt.B : cB;
        const int nrsA = has_next ? nxt.lda : cur.lda, nrsB = has_next ? nxt.ldb : cur.ldb;
        const int nt = cur.nt;
        for (int t = 0; t < nt; t += 2) {
            const bool last = (t == nt - 2);
            const char* a1 = cA + (size_t)(t + 1) * kstep;
            PG8_LDB(B0, 0, 0); PG8_LDB(B1, 0, 1); PG8_SCHED; PG8_LDA(At, 0, 0); PG8_STAGE(PG8_SA(1, 1), a1 + hsA, vA, rsA);
            if (last) {
                int R1, C1; stage_rc((wid * 64 + lane_id()) * 16, R1, C1); const int Rb1 = (R1 & ~31) + perm32(R1 & 31);
                rsA = nrsA; rsB = nrsB; vA = (unsigned)(R1 * rsA + C1 * 2); vB = (unsigned)(Rb1 * rsB + C1 * 2); hsA = (size_t)HALF * rsA; hsB = (size_t)HALF * rsB; }
            const char* a2 = last ? nA : cA + (size_t)(t + 2) * kstep; const char* b2 = last ? nB : cB + (size_t)(t + 2) * kstep;
            const char* a3 = a2 + kstep; const char* b3 = b2 + kstep;
            PG8_WAIT_V(8); PG8_WAIT_L(0); PG8_BAR; PG8_MMA(0, 0, At, B0); PG8_MMA(0, 1, At, B1); PG8_BAR; PG8_SCHED;
            PG8_LDA(At, 0, 1); PG8_STAGE(PG8_SB(0, 0), b2, vB, rsB); PG8_STAGE(PG8_SB(0, 1), b2 + hsB, vB, rsB); PG8_STAGE(PG8_SA(0, 0), a2, vA, rsA);
            PG8_WAIT_V(8); PG8_WAIT_L(0); PG8_BAR; PG8_MMA(1, 0, At, B0); PG8_MMA(1, 1, At, B1); PG8_BAR; PG8_SCHED;
            PG8_LDB(B0, 1, 0); PG8_LDB(B1, 1, 1); PG8_SCHED; PG8_LDA(At, 1, 0); PG8_STAGE(PG8_SA(0, 1), a2 + hsA, vA, rsA);
            PG8_WAIT_V(8); PG8_WAIT_L(0); PG8_BAR; PG8_MMA(0, 0, At, B0); PG8_MMA(0, 1, At, B1); PG8_BAR; PG8_SCHED;
            PG8_LDA(At, 1, 1); PG8_STAGE(PG8_SB(1, 0), b3, vB, rsB); PG8_STAGE(PG8_SB(1, 1), b3 + hsB, vB, rsB); PG8_STAGE(PG8_SA(1, 0), a3, vA, rsA);
            PG8_WAIT_V(8); PG8_WAIT_L(0); PG8_BAR; PG8_MMA(1, 0, At, B0); PG8_MMA(1, 1, At, B1); PG8_BAR; PG8_SCHED;
        }
        if (cur.act != 0) {
            if (wr == 0) PG8_BAR;
            E.after(acc, cur, wid);
            if (!has_next) break;
            if (wr == 1) PG8_BAR;
        }
        cur = nxt; cA = nA; cB = nB; ++si;
    }
    PG8_WAIT_V(0);
    PG8_BAR;
#undef PG8_SA
#undef PG8_SB
#undef PG8_STAGE
#undef PG8_LDA
#undef PG8_LDB
#undef PG8_MMA
#undef PG8_WAIT_V
#undef PG8_WAIT_L
#undef PG8_BAR
#undef PG8_SCHED
}
}
__device__ __forceinline__ v4u pk8(f32x4 a, f32x4 b) { v4u w; w.x = pk2(a[0], a[1]); w.y = pk2(a[2], a[3]); w.z = pk2(b[0], b[1]); w.w = pk2(b[2], b[3]); return w; }
__device__ __forceinline__ void unpack8(const v4u w, f32x4& a, f32x4& b) {
    a = (f32x4){__uint_as_float(w.x << 16), __uint_as_float(w.x & 0xffff0000u), __uint_as_float(w.y << 16), __uint_as_float(w.y & 0xffff0000u)};
    b = (f32x4){__uint_as_float(w.z << 16), __uint_as_float(w.z & 0xffff0000u), __uint_as_float(w.w << 16), __uint_as_float(w.w & 0xffff0000u)}; }
__device__ __forceinline__ void ld_bf8(const bf16* p, f32x4& a, f32x4& b) { const v4u w = *(const v4u*)p;
    a = (f32x4){__uint_as_float(w.x << 16), __uint_as_float(w.x & 0xffff0000u), __uint_as_float(w.y << 16), __uint_as_float(w.y & 0xffff0000u)};
    b = (f32x4){__uint_as_float(w.z << 16), __uint_as_float(w.z & 0xffff0000u), __uint_as_float(w.w << 16), __uint_as_float(w.w & 0xffff0000u)}; }


#define DPP_ROR1(x)  __int_as_float(__builtin_amdgcn_update_dpp(0, __float_as_int(x), 0x121, 0xF, 0xF, false))
#define DPP_ROL1(x)  __int_as_float(__builtin_amdgcn_update_dpp(0, __float_as_int(x), 0x12F, 0xF, 0xF, false))
#define DPP_XOR1(x)  __int_as_float(__builtin_amdgcn_update_dpp(0, __float_as_int(x), 0xB1, 0xF, 0xF, false))
struct P2Sched {
    int vcu; const char* HX; const char* WIN;
    __device__ __forceinline__ bool next(int i, pg8::Seg& s) const {
        const int x = vcu >> 5, j = vcu & 31, q = j >> 3; int tok = 8 * x + (j & 7);
        int act, wrow, u0, u1; bool sw = false;
        if (i == 0) { act = 1; wrow = R_CB + 256 * q; u1 = q; }
        else if (i <= 2) { act = 2; u1 = 2 * q + (i - 1); wrow = R_CCH + 256 * u1; }
        else if (i == 3) { act = 3; wrow = R_Q + 256 * q; u1 = q; }
        else if (i == 4) { act = 4; wrow = R_K + 256 * q; u1 = q; }
        else if (i <= 6) { act = 5; u1 = 2 * q + (i - 5); wrow = R_G + 256 * u1; }
        else if (i <= 8) { act = 6; u1 = 2 * q + (i - 7); wrow = R_GATE + 256 * u1; }
        else if (i == 9) { act = 7; sw = true; u0 = q; wrow = R_K + 256 * q; }
        else if (i <= 11) { act = 8; sw = true; u0 = 2 * q + (i - 10); wrow = R_V + 256 * u0; }
        else if (i == 12 && vcu < 48) { const int a = vcu % 12; tok = 64 + vcu / 12; sw = true; if (a < 4) { act = 7; u0 = a; wrow = R_K + 256 * a; } else { act = 8; u0 = a - 4; wrow = R_V + 256 * (a - 4); } }
        else return false;
        const char* hp = HX + (size_t)tok * 256 * 2048; const char* wp = WIN + (size_t)wrow * 2048;
        if (sw) { s.A = wp; s.B = hp; s.u0 = u0; s.u1 = tok; } else { s.A = hp; s.B = wp; s.u0 = tok; s.u1 = u1; }
        s.lda = 2048; s.ldb = 2048; s.nt = 16; s.act = act; s.u2 = 0; s.u3 = 0;
        return true;
    }
};
struct P2Epi {
    bf16 *ACAT, *KB, *KTF, *KTB, *VT, *SG, *CBU, *G1, *G2; const float *RC, *RS, *RCT, *RST, *DEC, *convw, *gnw;
    __device__ __forceinline__ void after(pg8::Acc& acc, const pg8::Seg& s, int wid) const { run(acc, s, wid, ACAT, KB, KTF, KTB, VT, SG, CBU, G1, G2, RC, RS, RCT, RST, DEC, convw, gnw); }
    static __device__ __forceinline__ void run(pg8::Acc& acc, const pg8::Seg& s, int wid, bf16* __restrict__ ACAT, bf16* __restrict__ KB, bf16* __restrict__ KTF, bf16* __restrict__ KTB, bf16* __restrict__ VT, bf16* __restrict__ SG, bf16* __restrict__ CBU, bf16* __restrict__ G1, bf16* __restrict__ G2, const float* __restrict__ RC, const float* __restrict__ RS, const float* __restrict__ RCT, const float* __restrict__ RST, const float* __restrict__ DEC, const float* __restrict__ convw, const float* __restrict__ gnw) {
        const int lane = lane_id(), wr = wid >> 2, wc = wid & 3, fr = lane & 15, fq = lane >> 4;
        int su0 = s.u0, su1 = s.u1; asm volatile("" : "+s"(su0), "+s"(su1));
        int rbase = 64 * wr + fr, cbase = 32 * wc + 8 * fq; const int act = s.act;
        asm volatile("" : "+v"(rbase), "+v"(cbase));
        if (act == 3 || act == 4) {
            const int h = su1;
            const float lf = DEC[h], lb = DEC[4 + h];
#pragma unroll
            for (int ai = 0; ai < 2; ++ai)
#pragma unroll
                for (int m = 0; m < 4; ++m) {
                    const int t = 256 * su0 + 128 * ai + rbase + 16 * m, n = t & (SEQ - 1), i = n & (CH - 1);
                    const float xf = ex2(lf * (float)(i + 1)), xb = ex2(lb * (float)(CH - i));
#pragma unroll
                    for (int bj = 0; bj < 2; ++bj) {
                        const int pos = bj ? (n & 63) : (n >> 6), p0 = 128 * bj + cbase;
                        const f32x4 cs = *(const f32x4*)(RC + pos * 64 + (cbase >> 1)), sn = *(const f32x4*)(RS + pos * 64 + (cbase >> 1));
                        const f32x4 v0 = acc[ai][bj][m][0], v1 = acc[ai][bj][m][1];
                        const f32x4 o0 = (f32x4){v0[0] * cs[0] - v0[1] * sn[0], v0[0] * sn[0] + v0[1] * cs[0], v0[2] * cs[1] - v0[3] * sn[1], v0[2] * sn[1] + v0[3] * cs[1]};
                        const f32x4 o1 = (f32x4){v1[0] * cs[2] - v1[1] * sn[2], v1[0] * sn[2] + v1[1] * cs[2], v1[2] * cs[3] - v1[3] * sn[3], v1[2] * sn[3] + v1[3] * cs[3]};
                        if (act == 3) { bf16* dst = ACAT + ((size_t)h * T + t) * 768 + p0; *(v4u*)(dst + 256) = pk8(o0 * xf, o1 * xf); *(v4u*)(dst + 512) = pk8(o0 * xb, o1 * xb); }
                        else *(v4u*)(KB + (size_t)t * QKW + h * DK + p0) = pk8(o0 * 0.0625f, o1 * 0.0625f);
                    }
                }
        } else if (act == 5 || act == 1) {
            bf16* base; int ld;
            if (act == 5) { base = SG + 256 * su1; ld = VW; } else { base = CBU + 256 * su1; ld = DM; }
#pragma unroll
            for (int bj = 0; bj < 2; ++bj) {
                f32x4 w0 = (f32x4){1.f, 1.f, 1.f, 1.f}, w1 = w0;
                if (act == 5) { w0 = *(const f32x4*)(gnw + 256 * su1 + 128 * bj + cbase); w1 = *(const f32x4*)(gnw + 256 * su1 + 128 * bj + cbase + 4); }
#pragma unroll
                for (int ai = 0; ai < 2; ++ai)
#pragma unroll
                    for (int m = 0; m < 4; ++m) {
                        const int t = 256 * su0 + 128 * ai + rbase + 16 * m;
                        f32x4 v0 = acc[ai][bj][m][0], v1 = acc[ai][bj][m][1];
                        if (act == 5) {
#pragma unroll
                            for (int e = 0; e < 4; ++e) { v0[e] = siluf(v0[e]) * w0[e]; v1[e] = siluf(v1[e]) * w1[e]; }
                        }
                        *(v4u*)(base + (size_t)t * ld + 128 * bj + cbase) = pk8(v0, v1);
                    }
            }
            if (act == 1) asm volatile("s_waitcnt vmcnt(0)" ::: "memory");
        } else if (act == 6) {
#pragma unroll
            for (int ai = 0; ai < 2; ++ai)
#pragma unroll
                for (int m = 0; m < 4; ++m) {
                    const int t = 256 * su0 + 128 * ai + rbase + 16 * m;
                    f32x4 g[2], r[2];
#pragma unroll
                    for (int n = 0; n < 2; ++n)
#pragma unroll
                        for (int e = 0; e < 4; ++e) { const float ea = 1.f + ex2(acc[ai][0][m][n][e] * -1.4426950408889634f), eb = 1.f + ex2(acc[ai][1][m][n][e] * -1.4426950408889634f);
                            g[n][e] = __builtin_amdgcn_rcpf(ea); r[n][e] = ea * __builtin_amdgcn_rcpf(eb); }
                    const size_t o = (size_t)t * DM + 128 * su1 + cbase;
                    *(v4u*)(G1 + o) = pk8(g[0], g[1]); *(v4u*)(G2 + o) = pk8(r[0], r[1]);
                }
        } else if (act == 2) {
            const int c0 = 128 * su1 + cbase;
            f32x4 w0[2], w1[2], w2[2];
#pragma unroll
            for (int n = 0; n < 2; ++n) { w0[n] = *(const f32x4*)(convw + c0 + 4 * n); w1[n] = *(const f32x4*)(convw + DM + c0 + 4 * n); w2[n] = *(const f32x4*)(convw + 2 * DM + c0 + 4 * n); }
#pragma unroll
            for (int ai = 0; ai < 2; ++ai) {
#pragma unroll
                for (int m = 0; m < 4; ++m)
#pragma unroll
                    for (int n = 0; n < 2; ++n) acc[ai][0][m][n] = acc[ai][0][m][n] * acc[ai][1][m][n];
#pragma unroll
                for (int m = 0; m < 4; ++m)
#pragma unroll
                    for (int n = 0; n < 2; ++n) {
                        const f32x4 cu = acc[ai][0][m][n]; f32x4 pv, nx;
#pragma unroll
                        for (int e = 0; e < 4; ++e) {
                            float a = DPP_ROR1(cu[e]), b = DPP_ROL1(cu[e]);
                            float ab = 0.f, bb = 0.f;
                            if (m > 0) ab = DPP_ROR1(acc[ai][0][m > 0 ? m - 1 : 0][n][e]);
                            if (m < 3) bb = DPP_ROL1(acc[ai][0][m < 3 ? m + 1 : 3][n][e]);
                            pv[e] = fr == 0 ? ab : a; nx[e] = fr == 15 ? bb : b;
                        }
                        acc[ai][1][m][n] = w0[n] * pv + w1[n] * cu + w2[n] * nx;
                    }
#pragma unroll
                for (int m = 0; m < 4; ++m) {
                    const int t = 256 * su0 + 128 * ai + rbase + 16 * m;
                    bf16* ptr = CBU + (size_t)t * DM + c0; f32x4 cb0, cb1; ld_bf8(ptr, cb0, cb1);
                    *(v4u*)ptr = pk8(cb0 * acc[ai][1][m][0], cb1 * acc[ai][1][m][1]);
                }
            }
        } else if (act == 7) {
            const int h = su0; const bool latent = su1 < 64;
            const float lf = DEC[h], lb = DEC[4 + h], gif = ex2(-lf), gb = ex2(lb);
#pragma unroll
            for (int bj = 0; bj < 2; ++bj) {
                const int tc0 = 256 * su1 + 128 * bj + cbase, n0 = tc0 & (SEQ - 1), j0 = tc0 & (CH - 1);
                float wf[8], wb[8];
                wf[0] = ex2(lf * (float)(CH - 1 - j0)) * 0.0625f; wb[0] = ex2(lb * (float)j0) * 0.0625f;
#pragma unroll
                for (int e = 1; e < 8; ++e) { wf[e] = wf[e - 1] * gif; wb[e] = wb[e - 1] * gb; }
#pragma unroll
                for (int ai = 0; ai < 2; ++ai)
#pragma unroll
                    for (int m = 0; m < 4; ++m) {
                        const int p = 128 * ai + rbase + 16 * m, fi = (p & 127) >> 1;
                        const f32x4 v0 = acc[ai][bj][m][0], v1 = acc[ai][bj][m][1];
                        f32x4 o0 = v0, o1 = v1;
                        if (latent) {
                            f32x4 p0, p1;
#pragma unroll
                            for (int e = 0; e < 4; ++e) { p0[e] = DPP_XOR1(v0[e]); p1[e] = DPP_XOR1(v1[e]); }
                            f32x4 c0, c1, s0, s1;
                            if (ai == 0) { const float cv = RC[(n0 >> 6) * 64 + fi], sv = RS[(n0 >> 6) * 64 + fi]; c0 = (f32x4){cv, cv, cv, cv}; c1 = c0; s0 = (f32x4){sv, sv, sv, sv}; s1 = s0; }
                            else { const float* cp = RCT + fi * 64 + (n0 & 63); const float* sp = RST + fi * 64 + (n0 & 63); c0 = *(const f32x4*)cp; c1 = *(const f32x4*)(cp + 4); s0 = *(const f32x4*)sp; s1 = *(const f32x4*)(sp + 4); }
                            if (fr & 1) { o0 = p0 * s0 + v0 * c0; o1 = p1 * s1 + v1 * c1; } else { o0 = v0 * c0 - p0 * s0; o1 = v1 * c1 - p1 * s1; }
                        }
                        f32x4 f0, f1, b0, b1;
#pragma unroll
                        for (int e = 0; e < 4; ++e) { f0[e] = o0[e] * wf[e]; f1[e] = o1[e] * wf[4 + e]; b0[e] = o0[e] * wb[e]; b1[e] = o1[e] * wb[4 + e]; }
                        const size_t off = (size_t)(h * DK + p) * TP + tc0;
                        *(v4u*)(KTF + off) = pk8(f0, f1); *(v4u*)(KTB + off) = pk8(b0, b1);
                    }
            }
        } else {
#pragma unroll
            for (int ai = 0; ai < 2; ++ai)
#pragma unroll
                for (int m = 0; m < 4; ++m)
#pragma unroll
                    for (int bj = 0; bj < 2; ++bj)
                        *(v4u*)(VT + (size_t)(256 * su0 + 128 * ai + rbase + 16 * m) * TP + 256 * su1 + 128 * bj + cbase) = pk8(acc[ai][bj][m][0], acc[ai][bj][m][1]);
        }
        pg8::acc_zero(acc);
    }
};


template <int MODE> struct P3Sched {
    int vcu; const char *VT, *KTF, *KTB, *ACAT, *KB;
    __device__ __forceinline__ bool next(int i, pg8::Seg& s) const {
        if (MODE == 0) {
            if (i >= NCH) return false;
            const int half = vcu & 1, dir = (vcu >> 1) & 1, h = (vcu >> 2) & 3, b = vcu >> 4;
            const int tc0 = i == 0 ? T + b * CTXL : b * SEQ + (dir ? (NCH - i) : (i - 1)) * CH;
            s.A = VT + ((size_t)(h * DV + half * 256) * TP + tc0) * 2; s.B = KTF + ((size_t)(dir * QKW + h * DK) * TP + tc0) * 2;
            s.lda = TP * 2; s.ldb = TP * 2; s.nt = 4; s.act = 1;
            s.u0 = b * SEQ + (dir ? (NCH - 1 - i) : i) * CH; s.u1 = h * DV + half * 256; s.u2 = dir * 4 + h; s.u3 = dir;
            return true;
        }
        const int u = vcu - 64 + 192 * i; if (i >= 2 || u >= NB * NCH * NH) return false;
        const int h = u & 3, t0 = (u >> 2) * CH;
        s.A = ACAT + (((size_t)h * T + t0) * 768 + 256) * 2; s.B = KB + ((size_t)t0 * QKW + h * DK) * 2;
        s.lda = 768 * 2; s.ldb = QKW * 2; s.nt = 4; s.act = 2; s.u0 = h; s.u1 = t0; s.u2 = 0; s.u3 = 0;
        return true;
    }
};
template <int MODE> struct P3Epi {
    bf16 *STF, *STB, *ACAT; const float* DEC;
    __device__ __forceinline__ void after(pg8::Acc& acc, const pg8::Seg& s, int wid) const { run(acc, s, wid, STF, STB, ACAT, DEC); }
    static __device__ __forceinline__ void run(pg8::Acc& acc, const pg8::Seg& s, int wid, bf16* __restrict__ STF, bf16* __restrict__ STB, bf16* __restrict__ ACAT, const float* __restrict__ DEC) {
        const int lane = lane_id(), wr = wid >> 2, wc = wid & 3, fr = lane & 15, fq = lane >> 4;
        int su0 = s.u0, su1 = s.u1, su2 = s.u2; asm volatile("" : "+s"(su0), "+s"(su1), "+s"(su2));
        int rbase = 64 * wr + fr, cbase = 32 * wc + 8 * fq; asm volatile("" : "+v"(rbase), "+v"(cbase));
        if (MODE == 0) {
            bf16* ST = s.u3 ? STB : STF; const float dec = ex2(DEC[su2] * (float)CH);
#pragma unroll
            for (int ai = 0; ai < 2; ++ai)
#pragma unroll
                for (int m = 0; m < 4; ++m)
#pragma unroll
                    for (int bj = 0; bj < 2; ++bj) {
                        *(v4u*)(ST + (size_t)(su1 + 128 * ai + rbase + 16 * m) * TP + su0 + 128 * bj + cbase) = pk8(acc[ai][bj][m][0], acc[ai][bj][m][1]);
                        acc[ai][bj][m][0] = acc[ai][bj][m][0] * dec; acc[ai][bj][m][1] = acc[ai][bj][m][1] * dec;
                    }
        } else {
            const float lf = DEC[su0], lb = DEC[4 + su0];
            bf16* Ah = ACAT + ((size_t)su0 * T + su1) * 768;
#pragma unroll
            for (int bj = 0; bj < 2; ++bj) {
                int j0 = 128 * bj + cbase; asm volatile("" : "+v"(j0));
                float cf[8], cb[8];
#pragma unroll
                for (int e = 0; e < 8; ++e) { cf[e] = ex2(-lf * (float)(j0 + e + 1)); cb[e] = ex2(lb * (float)(j0 + e)); }
#pragma unroll
                for (int ai = 0; ai < 2; ++ai)
#pragma unroll
                    for (int m = 0; m < 4; ++m) {
                        const int ii = 128 * ai + rbase + 16 * m; const float rb = ex2(-lb * (float)ii - lf * (float)(ii + 1));
#pragma unroll
                        for (int n = 0; n < 2; ++n)
#pragma unroll
                            for (int e = 0; e < 4; ++e) acc[ai][bj][m][n][e] *= (j0 + 4 * n + e <= ii) ? cf[4 * n + e] : cb[4 * n + e] * rb;
                        *(v4u*)(Ah + (size_t)ii * 768 + j0) = pk8(acc[ai][bj][m][0], acc[ai][bj][m][1]);
                    }
            }
            pg8::acc_zero(acc);
        }
    }
};
struct P4Sched {
    int vcu; const char* ws;
    __device__ __forceinline__ bool next(int i, pg8::Seg& s) const {
        if (i >= 6) return false;
        const int h = vcu & 3, t0 = (vcu >> 2) * CH, half = i / 3, sg = i % 3;
        s.A = ws + WS_ACAT + (((size_t)h * T + t0) * 768 + 256 * sg) * 2;
        const size_t boff = sg == 0 ? WS_VT : WS_ST + (size_t)(sg - 1) * VW * TP * 2;
        s.B = ws + boff + ((size_t)(h * DV + half * 256) * TP + t0) * 2;
        s.lda = 768 * 2; s.ldb = TP * 2; s.nt = 4; s.act = sg == 2 ? 1 + half : 0; s.u0 = t0; s.u1 = h; s.u2 = 0; s.u3 = 0;
        return true;
    }
};
struct P4Epi {
    bf16* YG; const bf16* SG; const float* gnw; LAS unsigned char* lds;
    __device__ __forceinline__ void after(pg8::Acc& acc, const pg8::Seg& s, int wid) const { run(acc, s, wid, YG, SG, gnw, lds); }
    static __device__ __forceinline__ void run(pg8::Acc& acc, const pg8::Seg& s, int wid, bf16* __restrict__ YG, const bf16* __restrict__ SG, const float* __restrict__ gnw, LAS unsigned char* lds) {
        const int lane = lane_id(), wr = wid >> 2, wc = wid & 3, fr = lane & 15, fq = lane >> 4;
        typedef float f32x2v __attribute__((ext_vector_type(2)));
        int su0 = s.u0, su1 = s.u1; asm volatile("" : "+s"(su0), "+s"(su1));
        int rbase = 64 * wr + fr, cbase = 32 * wc + 8 * fq; asm volatile("" : "+v"(rbase), "+v"(cbase));
        const int half = s.act - 1;
        LAS f32x2v* PS = (LAS f32x2v*)(lds + LDS_EPI) + half * 1024;
        LAS f32x2v* SR = (LAS f32x2v*)(lds + LDS_EPI);
#pragma unroll
        for (int ai = 0; ai < 2; ++ai)
#pragma unroll
            for (int m = 0; m < 4; ++m) {
                float sm = 0.f, sq = 0.f;
#pragma unroll
                for (int bj = 0; bj < 2; ++bj)
#pragma unroll
                    for (int n = 0; n < 2; ++n) { const f32x4 x = acc[ai][bj][m][n]; sm += (x[0] + x[1]) + (x[2] + x[3]); sq += (x[0] * x[0] + x[1] * x[1]) + (x[2] * x[2] + x[3] * x[3]); }
                sm += __shfl_xor(sm, 16); sm += __shfl_xor(sm, 32); sq += __shfl_xor(sq, 16); sq += __shfl_xor(sq, 32);
                if (fq == 0) PS[(128 * ai + rbase + 16 * m) * 4 + wc] = (f32x2v){sm, sq};
            }
        bf16* yrow = YG + (size_t)su0 * VW + su1 * DV;
        if (half == 0) {
#pragma unroll
            for (int ai = 0; ai < 2; ++ai)
#pragma unroll
                for (int m = 0; m < 4; ++m)
#pragma unroll
                    for (int bj = 0; bj < 2; ++bj) *(v4u*)(yrow + (size_t)(128 * ai + rbase + 16 * m) * VW + 128 * bj + cbase) = pk8(acc[ai][bj][m][0], acc[ai][bj][m][1]);
        } else {
            asm volatile("s_waitcnt vmcnt(0) lgkmcnt(0)" ::: "memory"); __builtin_amdgcn_s_barrier(); asm volatile("" ::: "memory");
            const int tid = wid * 64 + lane;
            float mean = 0.f, rstd = 0.f;
            if (tid < 256) { float sm = 0.f, sq = 0.f;
#pragma unroll
                for (int k = 0; k < 8; ++k) { const f32x2v p = ((LAS f32x2v*)(lds + LDS_EPI))[(k >> 2) * 1024 + tid * 4 + (k & 3)]; sm += p.x; sq += p.y; }
                mean = sm * (1.f / DV); rstd = rsqrtf(fmaxf(sq * (1.f / DV) - mean * mean, 0.f) + 1e-5f); }
            asm volatile("s_waitcnt lgkmcnt(0)" ::: "memory"); __builtin_amdgcn_s_barrier(); asm volatile("" ::: "memory");
            if (tid < 256) SR[tid] = (f32x2v){mean, rstd};
            asm volatile("s_waitcnt lgkmcnt(0)" ::: "memory"); __builtin_amdgcn_s_barrier(); asm volatile("" ::: "memory");
            const bf16* sgrow = SG + (size_t)su0 * VW + su1 * DV;
            v4u ld[2][6];
#define P4_LOADS(buf, g) do { const size_t _o = (size_t)(128 * ((g) >> 2) + rbase + 16 * ((g) & 3)) * VW + cbase; \
                ld[buf][0] = *(const v4u*)(yrow + _o); ld[buf][1] = *(const v4u*)(yrow + _o + 128); \
                ld[buf][2] = *(const v4u*)(sgrow + _o); ld[buf][3] = *(const v4u*)(sgrow + _o + 128); ld[buf][4] = *(const v4u*)(sgrow + _o + 256); ld[buf][5] = *(const v4u*)(sgrow + _o + 384); } while (0)
            P4_LOADS(0, 0);
#pragma unroll
            for (int g = 0; g < 8; ++g) {
                const int ai = g >> 2, m = g & 3, cur = g & 1;
                if (g < 7) P4_LOADS(cur ^ 1, g + 1);
                const int r = 128 * ai + rbase + 16 * m; const f32x2v st = SR[r]; const size_t o = (size_t)r * VW + cbase;
#pragma unroll
                for (int q = 0; q < 4; ++q) {
                    f32x4 y0, y1; if (q < 2) unpack8(ld[cur][q], y0, y1); else { y0 = acc[ai][q - 2][m][0]; y1 = acc[ai][q - 2][m][1]; }
                    f32x4 g0, g1; unpack8(ld[cur][2 + q], g0, g1);
                    *(v4u*)(yrow + o + 128 * q) = pk8((y0 - st.x) * st.y * g0, (y1 - st.x) * st.y * g1);
                }
            }
#undef P4_LOADS
            asm volatile("s_waitcnt lgkmcnt(0)" ::: "memory"); __builtin_amdgcn_s_barrier(); asm volatile("" ::: "memory");
        }
        pg8::acc_zero(acc);
    }
};
struct P5Sched {
    int vcu; const char *CBU, *YG, *WCAT;
    __device__ __forceinline__ bool next(int i, pg8::Seg& s) const {
        if (i >= 2) return false;
        const int x = vcu >> 5, j = vcu & 31, pm = 8 * x + (j & 7), pn = j >> 3;
        if (i == 0) { s.A = CBU + (size_t)pm * 256 * DM * 2; s.lda = DM * 2; s.B = WCAT + (size_t)pn * 256 * 3072 * 2; s.nt = 16; s.act = 1; }
        else { s.A = YG + (size_t)pm * 256 * VW * 2; s.lda = VW * 2; s.B = WCAT + ((size_t)pn * 256 * 3072 + 1024) * 2; s.nt = 32; s.act = 2; }
        s.ldb = 3072 * 2; s.u0 = pm; s.u1 = pn; s.u2 = 0; s.u3 = 0; return true;
    }
};
struct P5Epi {
    const bf16 *G1, *G2; bf16* MERGED;
    __device__ __forceinline__ void after(pg8::Acc& acc, const pg8::Seg& s, int wid) const { run(acc, s, wid, G1, G2, MERGED); }
    static __device__ __forceinline__ void run(pg8::Acc& acc, const pg8::Seg& s, int wid, const bf16* __restrict__ G1, const bf16* __restrict__ G2, bf16* __restrict__ MERGED) {
        const int lane = lane_id(), wr = wid >> 2, wc = wid & 3, fr = lane & 15, fq = lane >> 4;
        int su0 = s.u0, su1 = s.u1; asm volatile("" : "+s"(su0), "+s"(su1));
        int rbase = 64 * wr + fr, cbase = 32 * wc + 8 * fq; asm volatile("" : "+v"(rbase), "+v"(cbase));
#pragma unroll
        for (int ai = 0; ai < 2; ++ai)
#pragma unroll
            for (int m = 0; m < 4; ++m)
#pragma unroll
                for (int bj = 0; bj < 2; ++bj) {
                    const size_t o = (size_t)(256 * su0 + 128 * ai + rbase + 16 * m) * DM + 256 * su1 + 128 * bj + cbase;
                    f32x4 a0, a1; ld_bf8((s.act == 1 ? G2 : G1) + o, a0, a1);
                    if (s.act == 1) { acc[ai][bj][m][0] = acc[ai][bj][m][0] * a0; acc[ai][bj][m][1] = acc[ai][bj][m][1] * a1; }
                    else *(v4u*)(MERGED + o) = pk8(acc[ai][bj][m][0] * a0, acc[ai][bj][m][1] * a1);
                }
    }
};
struct P6Sched {
    int vcu; const char *MERGED, *WOUT;
    __device__ __forceinline__ bool next(int i, pg8::Seg& s) const {
        if (i >= 1) return false;
        const int x = vcu >> 5, j = vcu & 31, pm = 8 * x + (j & 7), pn = j >> 3;
        s.A = MERGED + (size_t)pm * 256 * DM * 2; s.B = WOUT + (size_t)pn * 256 * DM * 2; s.lda = DM * 2; s.ldb = DM * 2; s.nt = 16; s.act = 1; s.u0 = pm; s.u1 = pn; s.u2 = 0; s.u3 = 0; return true;
    }
};
struct P6Epi {
    const float *X, *MOD; float* X1;
    __device__ __forceinline__ void after(pg8::Acc& acc, const pg8::Seg& s, int wid) const { run(acc, s, wid, X, MOD, X1); }
    static __device__ __forceinline__ void run(pg8::Acc& acc, const pg8::Seg& s, int wid, const float* __restrict__ X, const float* __restrict__ MOD, float* __restrict__ X1) {
        const int lane = lane_id(), wr = wid >> 2, wc = wid & 3, fr = lane & 15, fq = lane >> 4;
        int su0 = s.u0, su1 = s.u1; asm volatile("" : "+s"(su0), "+s"(su1));
        int rbase = 64 * wr + fr, cbase = 32 * wc + 8 * fq; asm volatile("" : "+v"(rbase), "+v"(cbase));
        const float* g = MOD + ((256 * su0) / SEQ) * 6144 + 2048;
#pragma unroll
        for (int ai = 0; ai < 2; ++ai)
#pragma unroll
            for (int m = 0; m < 4; ++m)
#pragma unroll
                for (int bj = 0; bj < 2; ++bj)
#pragma unroll
                    for (int n = 0; n < 2; ++n) {
                        const int c = 256 * su1 + 128 * bj + cbase + 4 * n; const size_t o = (size_t)(256 * su0 + 128 * ai + rbase + 16 * m) * DM + c;
                        *(f32x4*)(X1 + o) = *(const f32x4*)(X + o) + *(const f32x4*)(g + c) * acc[ai][bj][m][n];
                    }
    }
};
struct MoeSched {
    int vcu, ntile, which; const char *A, *B; const LAS int* eoff;
    __device__ __forceinline__ bool next(int i, pg8::Seg& s) const {
        const int u = vcu + 256 * i; if (u >= ntile * 4) return false;
        const int mt = u >> 2, pn = u & 3; int e = 0;
#pragma unroll
        for (int q = 1; q < NE; ++q) e += (mt * 256 >= eoff[q]) ? 1 : 0;
        e = __builtin_amdgcn_readfirstlane(e);
        if (which == 0) { s.A = A + (size_t)mt * 256 * DM * 2; s.B = B + ((size_t)e * 1024 + pn * 256) * DM * 2; s.lda = DM * 2; s.ldb = DM * 2; s.nt = 16; }
        else { s.A = A + (size_t)mt * 256 * EH * 2; s.B = B + ((size_t)e * DM + pn * 256) * EH * 2; s.lda = EH * 2; s.ldb = EH * 2; s.nt = 8; }
        s.act = 1 + which; s.u0 = mt; s.u1 = pn; s.u2 = 0; s.u3 = 0; return true;
    }
};
struct MoeEpi {
    bf16 *ACT, *YB; const float* SLOTW;
    __device__ __forceinline__ void after(pg8::Acc& acc, const pg8::Seg& s, int wid) const { run(acc, s, wid, ACT, YB, SLOTW); }
    static __device__ __forceinline__ void run(pg8::Acc& acc, const pg8::Seg& s, int wid, bf16* __restrict__ ACT, bf16* __restrict__ YB, const float* __restrict__ SLOTW) {
        const int lane = lane_id(), wr = wid >> 2, wc = wid & 3, fr = lane & 15, fq = lane >> 4;
        int su0 = s.u0, su1 = s.u1; asm volatile("" : "+s"(su0), "+s"(su1));
        int rbase = 64 * wr + fr, cbase = 32 * wc + 8 * fq; asm volatile("" : "+v"(rbase), "+v"(cbase));
#pragma unroll
        for (int ai = 0; ai < 2; ++ai)
#pragma unroll
            for (int m = 0; m < 4; ++m) {
                const int row = 256 * su0 + 128 * ai + rbase + 16 * m;
                if (s.act == 1) {
                    f32x4 o[2];
#pragma unroll
                    for (int n = 0; n < 2; ++n)
#pragma unroll
                        for (int e = 0; e < 4; ++e) o[n][e] = siluf(acc[ai][0][m][n][e]) * acc[ai][1][m][n][e];
                    *(v4u*)(ACT + (size_t)row * EH + 128 * su1 + cbase) = pk8(o[0], o[1]);
                } else {
                    const float cw = SLOTW[row];
#pragma unroll
                    for (int bj = 0; bj < 2; ++bj) *(v4u*)(YB + (size_t)row * DM + 256 * su1 + 128 * bj + cbase) = pk8(acc[ai][bj][m][0] * cw, acc[ai][bj][m][1] * cw);
                }
            }
        pg8::acc_zero(acc);
    }
};

__global__ void __launch_bounds__(NTHREADS, 2) fwd_kernel(Params P) {
    extern __shared__ __attribute__((aligned(16))) unsigned char lds_raw[];
    Ctx C;
    C.lds = (LAS unsigned char*)lds_raw;
    C.tid = threadIdx.x; C.lane = C.tid & 63; C.wave = __builtin_amdgcn_readfirstlane(C.tid >> 6);
    C.gw = blockIdx.x * NWAVES + C.wave; C.ngw = gridDim.x * NWAVES;
    int lane = C.lane, tid = C.tid;
    unsigned char* ws = P.ws; GAS unsigned char* wsb = (GAS unsigned char*)P.ws; GAS float* outb = (GAS float*)P.out;
    unsigned* ctl = (unsigned*)(ws + WS_CTL);
    volatile LAS unsigned* MISC = (volatile LAS unsigned*)(C.lds + LDS_MISC);
    if (tid < 64) MISC[tid] = 0u;
    __syncthreads();
    XcdBarrier bar = xcd_barrier_post(ctl + CW_BAR, MISC + 8);
#define PIN(i) ((const float*)(const GAS float*)P.in[i])
#define GRID_BAR() do { xcd_barrier(bar); lane = lane_id(); tid = C.wave * 64 + lane; C.tid = tid; C.lane = lane; wsb = (GAS unsigned char*)P.ws; outb = (GAS float*)P.out; asm volatile("" : "+s"(wsb), "+s"(outb)); } while (0)
    const int vcu = (int)((blockIdx.x & 7) * (gridDim.x >> 3) + (blockIdx.x >> 3));

#define MOD ((float*)(GAS float*)(wsb + WS_SMALL + SM_MOD))
#define ROPE_C ((float*)(GAS float*)(wsb + WS_SMALL + SM_ROPE))
#define ROPE_S ((float*)(ROPE_C + 4096))
#define ROPE_CT ((float*)(ROPE_C + 8192))
#define ROPE_ST ((float*)(ROPE_C + 12288))
#define DEC ((float*)(GAS float*)(wsb + WS_SMALL + SM_DEC))
#define TOKE ((int*)(GAS int*)(wsb + WS_SMALL + SM_TOKE))
#define TOKP ((int*)(GAS int*)(wsb + WS_SMALL + SM_TOKP))
#define TOKW ((float*)(GAS float*)(wsb + WS_SMALL + SM_TOKW))
#define TOKS ((int*)(GAS int*)(wsb + WS_SMALL + SM_TOKS))
#define SLOTW ((float*)(GAS float*)(wsb + WS_SMALL + SM_SLOTW))
#define HIST ((int*)(GAS int*)(wsb + WS_SMALL + SM_HIST))
#define WCAT ((bf16*)(GAS bf16*)(wsb + WS_WCAT))
#define WOUT ((bf16*)(GAS bf16*)(wsb + WS_WOUT))
#define WRT ((bf16*)(GAS bf16*)(wsb + WS_WR))
#define CBU ((bf16*)(GAS bf16*)(wsb + WS_CBU))
#define SG ((bf16*)(GAS bf16*)(wsb + WS_SG))
#define ACAT ((bf16*)(GAS bf16*)(wsb + WS_ACAT))
#define KB ((bf16*)(GAS bf16*)(wsb + WS_KB))
#define KTF ((bf16*)(GAS bf16*)(wsb + WS_KT))
#define KTB ((bf16*)(KTF + (size_t)QKW * TP))
#define VT ((bf16*)(GAS bf16*)(wsb + WS_VT))
#define STF ((bf16*)(GAS bf16*)(wsb + WS_ST))
#define STB ((bf16*)(STF + (size_t)VW * TP))
#define HX ((bf16*)(GAS bf16*)(wsb + WS_HX))
#define WIN ((bf16*)(GAS bf16*)(wsb + WS_WIN))
#define TMPCCH ((bf16*)(GAS bf16*)(wsb + WS_TMPCCH))
#define YG ((bf16*)(GAS bf16*)(wsb + WS_YG))
#define MERGED ((bf16*)(GAS bf16*)(wsb + WS_MERGED))
#define HX2 ((bf16*)(GAS bf16*)(wsb + WS_HX2))
#define WE13 ((bf16*)(GAS bf16*)(wsb + WS_WE13))
#define WE2 ((bf16*)(GAS bf16*)(wsb + WS_WE2))
#define ACT ((bf16*)(GAS bf16*)(wsb + WS_ACT))
#define XS ((bf16*)(GAS bf16*)(wsb + WS_XS))
#define HID ((bf16*)(GAS bf16*)(wsb + WS_HID))
#define YB ((bf16*)(GAS bf16*)(wsb + WS_Y))
#define G1 ((bf16*)(GAS bf16*)outb)
#define G2 ((bf16*)(G1 + (size_t)T * DM))
#define X1 ((float*)outb)
    LAS float* scr = (LAS float*)(C.lds + C.wave * 16384);

    for (int _rep = 0; _rep < REP(0); ++_rep) {
    {
        const float* wmod = PIN(I_WMOD);
        LAS float* red = (LAS float*)(C.lds + LDS_EPI);
        for (int it = blockIdx.x; it < 192; it += gridDim.x) {
            const int cg = lane & 7, kr = lane >> 3;
            f32x4 a[5];
#pragma unroll
            for (int r = 0; r < 5; ++r) a[r] = (f32x4){0.f, 0.f, 0.f, 0.f};
            for (int i = 0; i < 16; ++i) {
                const int k = C.wave * 128 + i * 8 + kr;
                const f32x4 w4 = *(const f32x4*)(wmod + (size_t)k * 6144 + it * 32 + cg * 4);
#pragma unroll
                for (int r = 0; r < 5; ++r) { const float cv = r < 4 ? PIN(I_C)[r * DM + k] : PIN(I_CCTX)[k]; a[r] += w4 * siluf(cv); }
            }
#pragma unroll
            for (int r = 0; r < 5; ++r)
#pragma unroll
                for (int e = 0; e < 4; ++e) { float v = a[r][e]; v += __shfl_xor(v, 8); v += __shfl_xor(v, 16); v += __shfl_xor(v, 32); a[r][e] = v; }
            if (kr == 0) {
#pragma unroll
                for (int r = 0; r < 5; ++r)
#pragma unroll
                    for (int e = 0; e < 4; ++e) red[(C.wave * 5 + r) * 32 + cg * 4 + e] = a[r][e];
            }
            __syncthreads();
            if (tid < 160) { const int r = tid >> 5, col = tid & 31; float s = 0.f;
#pragma unroll
                for (int w = 0; w < 8; ++w) s += red[(w * 5 + r) * 32 + col];
                MOD[r * 6144 + it * 32 + col] = s + PIN(I_BMOD)[it * 32 + col]; }
            __syncthreads();
        }
        for (int it = C.gw; it < 16 * (PROJ_W / 32); it += C.ngw) {
            const int kb = it & 15, rb = it >> 4;
            transpose_item(PIN(I_WIN), PROJ_W, kb * 64, win_src(rb * 32 + (lane & 31)), WIN + (size_t)(rb * 32) * DM + kb * 64, DM, scr, lane);
        }
        if (blockIdx.x == gridDim.x - 1) {
            for (int i = tid; i < 4096; i += NTHREADS) { const int pos = i >> 6, f = i & 63;
                const float inv = powf(10000.0f, -(float)f / 64.0f), ang = (float)pos * inv;
                const float cv = cosf(ang), sv = sinf(ang); ROPE_C[i] = cv; ROPE_S[i] = sv; ROPE_CT[f * 64 + pos] = cv; ROPE_ST[f * 64 + pos] = sv; }
            if (tid < 8) { const float ld = PIN(I_DECAY)[tid]; DEC[tid] = log1pf(-expf(ld)) * 1.4426950408889634f; }
        }
    }
    GRID_BAR();
    }
    for (int _rep = 0; _rep < REP(1); ++_rep) {
    {
        for (int row = C.gw; row < T + TCX; row += C.ngw) {
            const bool isx = row < T; const int mr = isx ? row / SEQ : 4;
            const float* xr = isx ? PIN(I_X) + (size_t)row * DM : PIN(I_CTX) + (size_t)(row - T) * DM;
            f32x4 v[4]; float s2 = 0.f;
#pragma unroll
            for (int j = 0; j < 4; ++j) { v[j] = *(const f32x4*)(xr + 256 * j + 4 * lane); s2 += v[j][0] * v[j][0] + v[j][1] * v[j][1] + v[j][2] * v[j][2] + v[j][3] * v[j][3]; }
            const float rstd = rsqrtf(wave_sum(s2) * (1.f / DM) + 1e-6f);
#pragma unroll
            for (int j = 0; j < 4; ++j) { const int c = 256 * j + 4 * lane;
                const f32x4 w = *(const f32x4*)(PIN(I_N1W) + c), sh = *(const f32x4*)(MOD + mr * 6144 + c), sc = *(const f32x4*)(MOD + mr * 6144 + 1024 + c);
                const f32x4 o = (v[j] * rstd * w) * (sc + 1.f) + sh;
                st_bf4(HX + (size_t)row * DM + c, o); }
        }
        for (int i = C.gw * 64 + lane; i < 48 * DM; i += C.ngw * 64) { const int r = i >> 10, k = i & 1023;
            const float v = r < 4 ? PIN(I_RGW)[k * 4 + r] : r < 36 ? PIN(I_REW)[k * 32 + (r - 4)] : 0.f; WRT[i] = (bf16)f2bf(v); }
        for (int it = C.gw; it < (16 + 32 + 16) * 32; it += C.ngw) {
            const int rb = it & 31; int kb = it >> 5;
            if (kb < 16) transpose_item(PIN(I_WCONVO), DM, kb * 64, rb * 32 + (lane & 31), WCAT + (size_t)(rb * 32) * 3072 + kb * 64, 3072, scr, lane);
            else if (kb < 48) { kb -= 16; transpose_item(PIN(I_WRETO), DM, kb * 64, rb * 32 + (lane & 31), WCAT + (size_t)(rb * 32) * 3072 + 1024 + kb * 64, 3072, scr, lane); }
            else { kb -= 48; transpose_item(PIN(I_WOUT), DM, kb * 64, rb * 32 + (lane & 31), WOUT + (size_t)(rb * 32) * DM + kb * 64, DM, scr, lane); }
        }
    }
    GRID_BAR();
    }
    for (int _rep = 0; _rep < REP(2); ++_rep) {
    {
        P2Sched S{vcu, (const char*)HX, (const char*)WIN};
        P2Epi E{ACAT, KB, KTF, KTB, VT, SG, CBU, G1, G2, ROPE_C, ROPE_S, ROPE_CT, ROPE_ST, DEC, PIN(I_CONVW), PIN(I_GNW)};
        pg8::gemm_stream(C.lds, C.wave, S, E);
    }
    GRID_BAR();
    }
    for (int _rep = 0; _rep < REP(3); ++_rep) {
    {
        if (vcu < 64) { P3Sched<0> S{vcu, (const char*)VT, (const char*)KTF, (const char*)KTB, (const char*)ACAT, (const char*)KB}; P3Epi<0> E{STF, STB, ACAT, DEC}; pg8::gemm_stream(C.lds, C.wave, S, E); }
        else { P3Sched<1> S{vcu, (const char*)VT, (const char*)KTF, (const char*)KTB, (const char*)ACAT, (const char*)KB}; P3Epi<1> E{STF, STB, ACAT, DEC}; pg8::gemm_stream(C.lds, C.wave, S, E); }
    }
    GRID_BAR();
    }
    for (int _rep = 0; _rep < REP(4); ++_rep) {
    {
        P4Sched S{vcu, (const char*)wsb};
        P4Epi E{YG, SG, PIN(I_GNW), C.lds};
        pg8::gemm_stream(C.lds, C.wave, S, E);
    }
    GRID_BAR();
    }
    for (int _rep = 0; _rep < REP(5); ++_rep) {
    {
        P5Sched S{vcu, (const char*)CBU, (const char*)YG, (const char*)WCAT};
        P5Epi E{G1, G2, MERGED};
        pg8::gemm_stream(C.lds, C.wave, S, E);
    }
    GRID_BAR();
    }
    for (int _rep = 0; _rep < REP(6); ++_rep) {
    {
        P6Sched S{vcu, (const char*)MERGED, (const char*)WOUT};
        P6Epi E{PIN(I_X), MOD, X1};
        pg8::gemm_stream(C.lds, C.wave, S, E);
    }
    GRID_BAR();
    }
    for (int _rep = 0; _rep < REP(7); ++_rep) {
    {
        for (int row = C.gw; row < T; row += C.ngw) {
            const int mr = row / SEQ; const float* xr = X1 + (size_t)row * DM;
            f32x4 v[4]; float s2 = 0.f;
#pragma unroll
            for (int j = 0; j < 4; ++j) { v[j] = *(const f32x4*)(xr + 256 * j + 4 * lane); s2 += v[j][0] * v[j][0] + v[j][1] * v[j][1] + v[j][2] * v[j][2] + v[j][3] * v[j][3]; }
            const float rstd = rsqrtf(wave_sum(s2) * (1.f / DM) + 1e-6f);
#pragma unroll
            for (int j = 0; j < 4; ++j) { const int c = 256 * j + 4 * lane;
                const f32x4 w = *(const f32x4*)(PIN(I_N2W) + c), sh = *(const f32x4*)(MOD + mr * 6144 + 3072 + c), sc = *(const f32x4*)(MOD + mr * 6144 + 4096 + c);
                st_bf4(HX2 + (size_t)row * DM + c, (v[j] * rstd * w) * (sc + 1.f) + sh); }
        }
        for (int it = C.gw; it < NE * (16 * 32 + 8 * 32); it += C.ngw) {
            const int e = it / 768, r = it % 768;
            if (r < 512) { const int kb = r & 15, rb = r >> 4, rho = rb * 32 + (lane & 31), g = rho >> 8, w = rho & 255;
                transpose_item(PIN(I_W13) + (size_t)e * DM * 1024, 1024, kb * 64, w < 128 ? g * 128 + w : 512 + g * 128 + (w - 128), WE13 + ((size_t)e * 1024 + rb * 32) * DM + kb * 64, DM, scr, lane); }
            else { const int r2 = r - 512, kb = r2 & 7, rb = r2 >> 3;
                transpose_item(PIN(I_W2) + (size_t)e * EH * DM, DM, kb * 64, rb * 32 + (lane & 31), WE2 + ((size_t)e * DM + rb * 32) * EH + kb * 64, EH, scr, lane); }
        }
    }
    GRID_BAR();
    }
    {
        LAS float* lgp = (LAS float*)C.lds;
        LAS int* bh = (LAS int*)(C.lds + 32768);
        if (tid < 32) bh[tid] = 0;
        const int fr = lane & 15, fq = lane >> 4, grp = C.wave & 3, kh = C.wave >> 2;
        for (int tb = blockIdx.x; tb < T / 64; tb += gridDim.x) {
            f32x4 acc3[3];
#pragma unroll
            for (int j = 0; j < 3; ++j) acc3[j] = (f32x4){0.f, 0.f, 0.f, 0.f};
            const bf16* ap = HX2 + (size_t)(tb * 64 + grp * 16 + fr) * DM + kh * 512 + 8 * fq; const bf16* bp = WRT + (size_t)fr * DM + kh * 512 + 8 * fq;
#pragma unroll 8
            for (int k0 = 0; k0 < 512; k0 += 32) {
                const bf16x8 a = *(const bf16x8*)(ap + k0);
#pragma unroll
                for (int j = 0; j < 3; ++j) acc3[j] = __builtin_amdgcn_mfma_f32_16x16x32_bf16(*(const bf16x8*)(bp + (size_t)j * 16 * DM + k0), a, acc3[j], 0, 0, 0);
            }
#pragma unroll
            for (int j = 0; j < 3; ++j) *(LAS f32x4*)(lgp + ((kh * 4 + grp) * 16 + fr) * 48 + 16 * j + 4 * fq) = acc3[j];
            __syncthreads();
            if (kh == 0 && lane < 16) {
                const int t = tb * 64 + grp * 16 + lane; const LAS float* l0 = lgp + (grp * 16 + lane) * 48; const LAS float* l1 = l0 + 4 * 16 * 48;
                float gl[4];
#pragma unroll
                for (int g = 0; g < 4; ++g) gl[g] = l0[g] + l1[g] + PIN(I_RGB)[g];
                int gi = 0; float gm = gl[0];
#pragma unroll
                for (int g = 1; g < 4; ++g) if (gl[g] > gm) { gm = gl[g]; gi = g; }
                float gs = 0.f;
#pragma unroll
                for (int g = 0; g < 4; ++g) gs += __expf(gl[g] - gm);
                const float gwt = 1.f / gs;
                float el[8];
#pragma unroll
                for (int j = 0; j < 8; ++j) el[j] = l0[4 + gi * 8 + j] + l1[4 + gi * 8 + j] + PIN(I_REB)[gi * 8 + j];
                int i1 = 0; float m1 = el[0];
#pragma unroll
                for (int j = 1; j < 8; ++j) if (el[j] > m1) { m1 = el[j]; i1 = j; }
                int i2 = -1; float m2 = -3.0e38f;
#pragma unroll
                for (int j = 0; j < 8; ++j) if (j != i1 && el[j] > m2) { m2 = el[j]; i2 = j; }
                const float e2 = __expf(m2 - m1), w1 = 1.f / (1.f + e2), w2 = e2 * w1;
                const int ea = gi * 8 + i1, eb = gi * 8 + i2;
                const int pa = __hip_atomic_fetch_add(bh + ea, 1, __ATOMIC_RELAXED, __HIP_MEMORY_SCOPE_WORKGROUP), pb = __hip_atomic_fetch_add(bh + eb, 1, __ATOMIC_RELAXED, __HIP_MEMORY_SCOPE_WORKGROUP);
                TOKE[t * 2] = ea; TOKE[t * 2 + 1] = eb; TOKP[t * 2] = pa; TOKP[t * 2 + 1] = pb; TOKW[t * 2] = gwt * w1; TOKW[t * 2 + 1] = gwt * w2;
            }
            __syncthreads();
            if (tid < 32) { HIST[tb * 32 + tid] = bh[tid]; bh[tid] = 0; }
            __syncthreads();
        }
    }
    GRID_BAR();
    LAS int* eoff = (LAS int*)(C.lds + LDS_EOFF);
    {
        LAS int* red = (LAS int*)C.lds;
        LAS int* ebase = (LAS int*)(C.lds + 8192);
        { const int e = tid & 31, ch = tid >> 5; int sa = 0, sp = 0;
#pragma unroll
          for (int k = 0; k < 16; ++k) { const int bb = ch * 16 + k; const int v = HIST[bb * 32 + e]; sa += v; sp += bb < (int)blockIdx.x ? v : 0; }
          red[ch * 32 + e] = sa; red[512 + ch * 32 + e] = sp; }
        __syncthreads();
        if (tid < 64) {
            int tot = 0, pre = 0;
            if (lane < NE) {
#pragma unroll
                for (int k = 0; k < 16; ++k) { tot += red[k * 32 + lane]; pre += red[512 + k * 32 + lane]; } }
            int v = (tot + 255) & ~255;
#pragma unroll
            for (int o = 1; o < 32; o <<= 1) { const int u = __shfl_up(v, o); if (lane >= o) v += u; }
            if (lane < NE) { eoff[lane + 1] = v; if (lane == 0) eoff[0] = 0; ebase[lane] = v - ((tot + 255) & ~255) + pre; red[1024 + lane] = tot; }
        }
        __syncthreads();
    }
    const int nslot = __builtin_amdgcn_readfirstlane(eoff[NE]);
    {
        LAS int* ebase = (LAS int*)(C.lds + 8192); LAS int* etot = (LAS int*)C.lds + 1024;
        for (int tb = blockIdx.x; tb < T / 64; tb += gridDim.x) {
            const int r = tb * 128 + C.wave * 16 + (lane & 15);
            const int slot_l = ebase[TOKE[r]] + TOKP[r];
            if (lane < 16) { TOKS[r] = slot_l; SLOTW[slot_l] = TOKW[r]; }
#pragma unroll
            for (int g = 0; g < 4; ++g) {
                v4u a[4], b2[4]; int sl[4];
#pragma unroll
                for (int u = 0; u < 4; ++u) { const int rr = tb * 128 + C.wave * 16 + g * 4 + u; sl[u] = __shfl(slot_l, g * 4 + u); const v4u* src = (const v4u*)(HX2 + (size_t)(rr >> 1) * DM); a[u] = src[lane]; b2[u] = src[lane + 64]; }
#pragma unroll
                for (int u = 0; u < 4; ++u) { v4u* dst = (v4u*)(XS + (size_t)sl[u] * DM); dst[lane] = a[u]; dst[lane + 64] = b2[u]; }
            }
        }
#pragma unroll 1
        for (int e = 0; e < NE; ++e) {
            const int off = eoff[e], nxt = eoff[e + 1], c = etot[e];
            for (int r = off + c + C.gw; r < nxt; r += C.ngw) { v4u* dst = (v4u*)(XS + (size_t)r * DM); const v4u z = (v4u){0u, 0u, 0u, 0u}; dst[lane] = z; dst[lane + 64] = z; if (lane == 0) SLOTW[r] = 0.f; }
        }
    }
    GRID_BAR();
    for (int _rep = 0; _rep < REP(10); ++_rep) {
    {
        MoeSched S{vcu, nslot >> 8, 0, (const char*)XS, (const char*)WE13, eoff};
        MoeEpi E{ACT, YB, SLOTW};
        pg8::gemm_stream(C.lds, C.wave, S, E);
    }
    GRID_BAR();
    }
    for (int _rep = 0; _rep < REP(11); ++_rep) {
    {
        MoeSched S{vcu, nslot >> 8, 1, (const char*)ACT, (const char*)WE2, eoff};
        MoeEpi E{ACT, YB, SLOTW};
        pg8::gemm_stream(C.lds, C.wave, S, E);
    }
    GRID_BAR();
    }
    {
        for (int row = C.gw; row < T; row += C.ngw) {
            const int mr = row / SEQ; float* xr = X1 + (size_t)row * DM;
            const int s0 = TOKS[row * 2], s1 = TOKS[row * 2 + 1];
            f32x4 v[4]; float s2 = 0.f;
#pragma unroll
            for (int j = 0; j < 4; ++j) { const int c = 256 * j + 4 * lane;
                const f32x4 y = ld_bf4(YB + (size_t)s0 * DM + c) + ld_bf4(YB + (size_t)s1 * DM + c);
                v[j] = *(const f32x4*)(xr + c) + *(const f32x4*)(MOD + mr * 6144 + 5120 + c) * y;
                s2 += v[j][0] * v[j][0] + v[j][1] * v[j][1] + v[j][2] * v[j][2] + v[j][3] * v[j][3]; }
            const float rstd = rsqrtf(wave_sum(s2) * (1.f / DM) + 1e-6f);
#pragma unroll
            for (int j = 0; j < 4; ++j) { const int c = 256 * j + 4 * lane; *(f32x4*)(xr + c) = v[j] * rstd * *(const f32x4*)(PIN(I_FNW) + c); }
        }
    }
}

extern "C" void kernel_launch(void* const* d_in, const int* in_sizes, int n_in, void* d_out, int out_size, void* d_ws, size_t ws_size, hipStream_t stream) {
    static int grid = 0;
    if (grid == 0) {
        if (n_in != 22 || out_size != T * DM || ws_size < WS_END) { fprintf(stderr, "kernel_launch: unexpected problem (n_in %d, out %d, ws %zu, need %zu)\n", n_in, out_size, ws_size, (size_t)WS_END); grid = -1; return; }
        int dev = 0, cus = 0, per_cu = 0;
        if (hipGetDevice(&dev) != hipSuccess || hipDeviceGetAttribute(&cus, hipDeviceAttributeMultiprocessorCount, dev) != hipSuccess) { grid = -1; return; }
        if (hipFuncSetAttribute((const void*)fwd_kernel, hipFuncAttributeMaxDynamicSharedMemorySize, LDS_BYTES) != hipSuccess) { fprintf(stderr, "kernel_launch: hipFuncSetAttribute failed\n"); grid = -1; return; }
        if (hipOccupancyMaxActiveBlocksPerMultiprocessor(&per_cu, (const void*)fwd_kernel, NTHREADS, LDS_BYTES) != hipSuccess || per_cu < 1) { fprintf(stderr, "kernel_launch: occupancy query reports %d\n", per_cu); per_cu = 1; }
        (void)hipGetLastError();
        grid = cus;
    }
    if (grid < 0) return;
    (void)hipMemsetAsync((char*)d_ws + WS_CTL, 0, 1 * MiB, stream);
    Params p{};
    for (int i = 0; i < 22; ++i) p.in[i] = (const float*)d_in[i];
    p.out = (float*)d_out; p.ws = (unsigned char*)d_ws;
    hipLaunchKernelGGL(fwd_kernel, dim3(grid), dim3(NTHREADS), LDS_BYTES, stream, p);
}
```
